# Optimizing an MI355X kernel written in HIP

```python
import jax, jax.numpy as jnp
from jax import lax
import numpy as np

D_MODEL = 1024
BATCH = 8
SEQ = 2048
DEPTH = 4

CTX_LEN = 256
GRID_W = 64
HEAD_DIM = 64
A_HEADS = 4
A_KV_HEADS = 2
A_WINDOW = 128
A_BLOCK = 128
B_HEADS = 4
B_WIN_H = 8
B_WIN_W = 16
C_HEADS = 4
C_Q_RANK = 256
C_KV_RANK = 128
C_NOPE = 64
C_ROPE = 32
C_V = 64
C_BLOCK = 128
D_GROUPS = 4
D_CHUNK = 128
A_W = A_HEADS * HEAD_DIM
A_KV_W = A_KV_HEADS * HEAD_DIM
B_W = B_HEADS * HEAD_DIM
C_W = C_HEADS * C_V
D_WIDTH = D_GROUPS * HEAD_DIM
MIX_W = A_W + B_W + C_W + D_WIDTH
IN_SIZES = (A_KV_W, A_KV_W, B_W, B_W, C_KV_RANK, C_ROPE, A_W, B_W, C_Q_RANK, D_WIDTH, D_WIDTH)
KV_COLS = 2 * A_KV_W + 2 * B_W + C_KV_RANK + C_ROPE
IN_W = KV_COLS + A_W + B_W + C_Q_RANK + 2 * D_WIDTH
FF_HIDDEN = -(-8 * D_MODEL // (3 * 256)) * 256
ROPE_BASE = 10000.0
LN_EPS = 1e-6
NEG_INF = -1e30
DN_ALPHA = (2 * DEPTH) ** 0.25
DN_BETA = (8 * DEPTH) ** -0.25

kernel_name = "hybrid_parallel_group_diffusion_trunk"


def _layer_norm(x, g, b):
    xf = x.astype(jnp.float32)
    xc = xf - jnp.mean(xf, -1, keepdims=True)
    var = jnp.mean(xc * xc, -1, keepdims=True)
    return (xc * lax.rsqrt(var + LN_EPS) * g.astype(jnp.float32) + b.astype(jnp.float32)).astype(x.dtype)


def _rms_norm(x, g):
    xf = x.astype(jnp.float32)
    return (xf * lax.rsqrt(jnp.mean(xf * xf, -1, keepdims=True) + LN_EPS) * g.astype(jnp.float32)).astype(x.dtype)


def _rope_1d(x, pos):
    d = x.shape[-1]
    inv = ROPE_BASE ** (-jnp.arange(0, d, 2, dtype=jnp.float32) / d)
    ang = pos.astype(jnp.float32)[:, None] * inv[None, :]
    cos = jnp.cos(ang)[None, :, None, :]
    sin = jnp.sin(ang)[None, :, None, :]
    x1, x2 = jnp.split(x.astype(jnp.float32), 2, axis=-1)
    return jnp.concatenate([x1 * cos - x2 * sin, x1 * sin + x2 * cos], -1).astype(x.dtype)


def _axial_rope(x, rows, cols):
    half = x.shape[-1] // 2
    return jnp.concatenate([_rope_1d(x[..., :half], rows), _rope_1d(x[..., half:], cols)], -1)


def _heads(t, n, d=HEAD_DIM):
    return t.reshape(t.shape[:-1] + (n, d))


def _dense_attn(q, k, v, scale):
    s = jnp.einsum('bqhd,bkhd->bhqk', q, k).astype(jnp.float32) * scale
    p = jax.nn.softmax(s, axis=-1).astype(v.dtype)
    return jnp.einsum('bhqk,bkhd->bqhd', p, v)


def _mixer_a(q, k, v, kc, vc, qc, sink, rows, cols):
    bsz, seq = q.shape[:2]
    nctx = kc.shape[1]
    grp = A_HEADS // A_KV_HEADS
    nb = seq // A_BLOCK
    nl = 3 * A_BLOCK
    scale = HEAD_DIM ** -0.5
    q = _axial_rope(q, rows, cols)
    k = _axial_rope(k, rows, cols)
    qb = q.reshape(bsz, nb, A_BLOCK, A_KV_HEADS, grp, HEAD_DIM)

    def band(t):
        tp = jnp.pad(t, ((0, 0), (A_BLOCK, A_BLOCK), (0, 0), (0, 0))).reshape(bsz, nb + 2, A_BLOCK, A_KV_HEADS, HEAD_DIM)
        return jnp.concatenate([tp[:, :-2], tp[:, 1:-1], tp[:, 2:]], axis=2)

    kb, vb = band(k), band(v)
    qpos = jnp.arange(seq).reshape(nb, A_BLOCK)
    kpos = (jnp.arange(nb)[:, None] - 1) * A_BLOCK + jnp.arange(nl)[None, :]
    valid = ((jnp.abs(qpos[:, :, None] - kpos[:, None, :]) <= A_WINDOW)
             & (kpos[:, None, :] >= 0) & (kpos[:, None, :] < seq))
    s_loc = jnp.einsum('bnqhgd,bnkhd->bnhgqk', qb, kb).astype(jnp.float32) * scale
    s_loc = jnp.where(valid[None, :, None, None], s_loc, NEG_INF)
    s_ctx = jnp.einsum('bnqhgd,bkhd->bnhgqk', qb, kc).astype(jnp.float32) * scale
    sink_f = sink.astype(jnp.float32).reshape(A_KV_HEADS, grp, 1, 1)
    s_sink = jnp.broadcast_to(sink_f, s_ctx.shape[:-1] + (1,))
    p = jax.nn.softmax(jnp.concatenate([s_loc, s_ctx, s_sink], -1), axis=-1).astype(v.dtype)
    o = (jnp.einsum('bnhgqk,bnkhd->bnqhgd', p[..., :nl], vb)
         + jnp.einsum('bnhgqk,bkhd->bnqhgd', p[..., nl:nl + nctx], vc))
    y = o.reshape(bsz, seq, A_W)
    if qc is None:
        return y, None
    qcg = qc.reshape(bsz, nctx, A_KV_HEADS, grp, HEAD_DIM)
    sc = jnp.einsum('bqhgd,bkhd->bhgqk', qcg, kc).astype(jnp.float32) * scale
    pc = jax.nn.softmax(jnp.concatenate([sc, jnp.broadcast_to(sink_f, sc.shape[:-1] + (1,))], -1), axis=-1)
    yc = jnp.einsum('bhgqk,bkhd->bqhgd', pc[..., :nctx].astype(v.dtype), vc).reshape(bsz, nctx, A_W)
    return y, yc


def _mixer_b(q, k, v, kc, vc, qc, rpb):
    bsz, seq = q.shape[:2]
    n_rows = seq // GRID_W
    wh = min(B_WIN_H, n_rows)
    scale = HEAD_DIM ** -0.5
    qg = q.reshape(bsz, n_rows, GRID_W, B_HEADS, HEAD_DIM)
    kg = k.reshape(bsz, n_rows, GRID_W, B_HEADS, HEAD_DIM)
    vg = v.reshape(bsz, n_rows, GRID_W, B_HEADS, HEAD_DIM)
    r = jnp.arange(n_rows)
    r_start = jnp.clip(r - wh // 2, 0, n_rows - wh)
    row_idx = r_start[:, None] + jnp.arange(wh)[None, :]
    kn = kg[:, row_idx]
    vn = vg[:, row_idx]
    cidx = jnp.arange(GRID_W)
    c_start = jnp.clip(cidx - B_WIN_W // 2, 0, GRID_W - B_WIN_W)
    col_ok = (cidx[None, :] >= c_start[:, None]) & (cidx[None, :] < c_start[:, None] + B_WIN_W)
    dr_i = row_idx - r[:, None] + (B_WIN_H - 1)
    dc_i = jnp.clip(cidx[None, :] - cidx[:, None] + (B_WIN_W - 1), 0, 2 * B_WIN_W - 2)
    bias = rpb.astype(jnp.float32)[:, dr_i[:, None, :, None], dc_i[None, :, None, :]]
    bias = jnp.transpose(bias, (1, 0, 2, 3, 4))
    s = jnp.einsum('brqhd,brjkhd->brhqjk', qg, kn).astype(jnp.float32) * scale + bias[None]
    s = jnp.where(col_ok[:, None, :], s, NEG_INF).reshape(bsz, n_rows, B_HEADS, GRID_W, wh * GRID_W)
    s_ctx = jnp.einsum('brqhd,bkhd->brhqk', qg, kc).astype(jnp.float32) * scale
    p = jax.nn.softmax(jnp.concatenate([s, s_ctx], -1), axis=-1).astype(v.dtype)
    p_loc = p[..., :wh * GRID_W].reshape(bsz, n_rows, B_HEADS, GRID_W, wh, GRID_W)
    o = (jnp.einsum('brhqjk,brjkhd->brqhd', p_loc, vn)
         + jnp.einsum('brhqk,bkhd->brqhd', p[..., wh * GRID_W:], vc))
    y = o.reshape(bsz, seq, B_W)
    if qc is None:
        return y, None
    yc = _dense_attn(qc, kc, vc, scale).reshape(bsz, kc.shape[1], B_W)
    return y, yc


def _mixer_c(cq, ckv, kr, ckv_c, kr_c, cq_c, q_norm, kv_norm, w_uq, w_ukv, rows, cols):
    bsz, seq = cq.shape[:2]
    nctx = ckv_c.shape[1]
    scale = (C_NOPE + C_ROPE) ** -0.5

    def queries(t):
        qh = (_rms_norm(t, q_norm) @ w_uq).reshape(t.shape[:2] + (C_HEADS, C_NOPE + C_ROPE))
        return qh[..., :C_NOPE], qh[..., C_NOPE:]

    def keys_values(t, rk):
        kv = (_rms_norm(t, kv_norm) @ w_ukv).reshape(t.shape[:2] + (C_HEADS, C_NOPE + C_V))
        rk_h = jnp.broadcast_to(rk[:, :, None, :], rk.shape[:2] + (C_HEADS, C_ROPE))
        return jnp.concatenate([kv[..., :C_NOPE], rk_h], -1), kv[..., C_NOPE:]

    k_lat, v_lat = keys_values(ckv, _axial_rope(kr[:, :, None, :], rows, cols)[:, :, 0])
    k_ctx, v_ctx = keys_values(ckv_c, kr_c)
    k_all = jnp.concatenate([k_ctx, k_lat], axis=1)
    v_all = jnp.concatenate([v_ctx, v_lat], axis=1)
    qn, qr = queries(cq)
    q = jnp.concatenate([qn, _axial_rope(qr, rows, cols)], -1)
    nb = seq // C_BLOCK
    qb = jnp.moveaxis(q.reshape(bsz, nb, C_BLOCK, C_HEADS, C_NOPE + C_ROPE), 1, 0)
    o = lax.map(lambda qblk: _dense_attn(qblk, k_all, v_all, scale), qb)
    y = jnp.moveaxis(o, 0, 1).reshape(bsz, seq, C_W)
    if cq_c is None:
        return y, None
    qnc, qrc = queries(cq_c)
    yc = _dense_attn(jnp.concatenate([qnc, qrc], -1), k_ctx, v_ctx, scale).reshape(bsz, nctx, C_W)
    return y, yc


def _mixer_d(du, dv, ln_g, ln_b, ws, bs):
    bsz, length = du.shape[:2]
    nc = length // D_CHUNK
    u = jax.nn.gelu(du)
    v = _layer_norm(jax.nn.gelu(dv), ln_g, ln_b)
    vc = v.reshape(bsz, nc, D_CHUNK, D_GROUPS, HEAD_DIM)
    mixed = jnp.einsum('gts,bcsgd->bctgd', ws, vc) + bs.T[:, :, None]
    return u * mixed.reshape(bsz, length, D_WIDTH)


def _swiglu(h, w_gu, w_down):
    g, u = jnp.split(h @ w_gu, 2, axis=-1)
    return (jax.nn.silu(g) * u) @ w_down


def setup_inputs(seed: int = 0) -> dict:
    key = jax.random.key(seed)
    ks = jax.random.split(key, 24)

    def nrm(k, shape, s):
        return jax.random.normal(k, shape, jnp.float32) * s

    L = DEPTH
    return {
        "x": nrm(ks[0], (BATCH, SEQ, D_MODEL), 1.0),
        "c": nrm(ks[1], (BATCH, D_MODEL), 1.0),
        "ctx": nrm(ks[2], (BATCH, CTX_LEN, D_MODEL), 1.0),
        "c_ctx": nrm(ks[3], (D_MODEL,), 1.0),
        "w_mod": nrm(ks[4], (L, D_MODEL, 6 * D_MODEL), 0.5 * D_MODEL ** -0.5),
        "b_mod": nrm(ks[5], (L, 6 * D_MODEL), 0.02),
        "w_in": nrm(ks[6], (L, D_MODEL, IN_W), D_MODEL ** -0.5),
        "a_sink": nrm(ks[7], (L, A_HEADS), 0.5),
        "b_rpb": nrm(ks[8], (L, B_HEADS, 2 * B_WIN_H - 1, 2 * B_WIN_W - 1), 0.2),
        "c_q_norm": 1.0 + nrm(ks[9], (L, C_Q_RANK), 0.02),
        "c_kv_norm": 1.0 + nrm(ks[10], (L, C_KV_RANK), 0.02),
        "c_w_uq": nrm(ks[11], (L, C_Q_RANK, C_HEADS * (C_NOPE + C_ROPE)), C_Q_RANK ** -0.5),
        "c_w_ukv": nrm(ks[12], (L, C_KV_RANK, C_HEADS * (C_NOPE + C_V)), C_KV_RANK ** -0.5),
        "d_ln_g": 1.0 + nrm(ks[13], (L, D_WIDTH), 0.02),
        "d_ln_b": nrm(ks[14], (L, D_WIDTH), 0.02),
        "d_ws": nrm(ks[15], (L, D_GROUPS, D_CHUNK, D_CHUNK), D_CHUNK ** -0.5),
        "d_bs": 1.0 + nrm(ks[16], (L, D_GROUPS, D_CHUNK), 0.02),
        "w_out": nrm(ks[17], (L, MIX_W, D_MODEL), DN_BETA * MIX_W ** -0.5),
        "ln1_g": 1.0 + nrm(ks[18], (L, D_MODEL), 0.02),
        "ln1_b": nrm(ks[19], (L, D_MODEL), 0.02),
        "w_gu": nrm(ks[20], (L, D_MODEL, 2 * FF_HIDDEN), D_MODEL ** -0.5),
        "w_down": nrm(ks[21], (L, FF_HIDDEN, D_MODEL), DN_BETA * FF_HIDDEN ** -0.5),
        "ln2_g": 1.0 + nrm(ks[22], (L, D_MODEL), 0.02),
        "ln2_b": nrm(ks[23], (L, D_MODEL), 0.02),
    }


def reference(x, c, ctx, c_ctx, w_mod, b_mod, w_in, a_sink, b_rpb, c_q_norm, c_kv_norm, c_w_uq, c_w_ukv,
              d_ln_g, d_ln_b, d_ws, d_bs, w_out, ln1_g, ln1_b, w_gu, w_down, ln2_g, ln2_b):
    seq = x.shape[1]
    t = jnp.arange(seq)
    rows, cols = t // GRID_W, t % GRID_W
    split_at = np.cumsum(IN_SIZES)[:-1].tolist()
    s_c = jax.nn.silu(c)
    s_cc = jax.nn.silu(c_ctx)
    for l in range(DEPTH):
        last = l == DEPTH - 1
        m = jnp.split((s_c @ w_mod[l] + b_mod[l])[:, None, :], 6, axis=-1)
        mc = jnp.split(s_cc @ w_mod[l] + b_mod[l], 6, axis=-1)
        h = x * (1 + m[1]) + m[0]
        hc = ctx * (1 + mc[1]) + mc[0]
        ak, av, bk, bv, cckv, ckr, aq, bq, ccq, du, dv = jnp.split(h @ w_in[l], split_at, axis=-1)
        if last:
            akc, avc, bkc, bvc, cckvc, ckrc = jnp.split(hc @ w_in[l][:, :KV_COLS], split_at[:5], axis=-1)
            aqc = bqc = ccqc = None
        else:
            akc, avc, bkc, bvc, cckvc, ckrc, aqc, bqc, ccqc, duc, dvc = jnp.split(hc @ w_in[l], split_at, axis=-1)
            aqc, bqc = _heads(aqc, A_HEADS), _heads(bqc, B_HEADS)
        ya, yac = _mixer_a(_heads(aq, A_HEADS), _heads(ak, A_KV_HEADS), _heads(av, A_KV_HEADS),
                           _heads(akc, A_KV_HEADS), _heads(avc, A_KV_HEADS), aqc, a_sink[l], rows, cols)
        yb, ybc = _mixer_b(_heads(bq, B_HEADS), _heads(bk, B_HEADS), _heads(bv, B_HEADS),
                           _heads(bkc, B_HEADS), _heads(bvc, B_HEADS), bqc, b_rpb[l])
        yc, ycc = _mixer_c(ccq, cckv, ckr, cckvc, ckrc, ccqc, c_q_norm[l], c_kv_norm[l],
                           c_w_uq[l], c_w_ukv[l], rows, cols)
        yd = _mixer_d(du, dv, d_ln_g[l], d_ln_b[l], d_ws[l], d_bs[l])
        y = jnp.concatenate([ya, yb, yc, yd], axis=-1) @ w_out[l]
        x = _layer_norm(DN_ALPHA * x + m[2] * y, ln1_g[l], ln1_b[l])
        x = _layer_norm(DN_ALPHA * x + m[5] * _swiglu(x * (1 + m[4]) + m[3], w_gu[l], w_down[l]),
                        ln2_g[l], ln2_b[l])
        if not last:
            ydc = _mixer_d(duc, dvc, d_ln_g[l], d_ln_b[l], d_ws[l], d_bs[l])
            y_ctx = jnp.concatenate([yac, ybc, ycc, ydc], axis=-1) @ w_out[l]
            ctx = _layer_norm(DN_ALPHA * ctx + mc[2] * y_ctx, ln1_g[l], ln1_b[l])
            ctx = _layer_norm(DN_ALPHA * ctx + mc[5] * _swiglu(ctx * (1 + mc[4]) + mc[3], w_gu[l], w_down[l]),
                              ln2_g[l], ln2_b[l])
    return x
```

```cpp
#include <hip/hip_runtime.h>
#include <cstdio>
#include <cstdint>

#ifndef MK_ONE_LAUNCH
#define MK_ONE_LAUNCH 1
#endif

#define LAS __attribute__((address_space(3)))
#define GAS __attribute__((address_space(1)))
typedef unsigned short bf16_t;
typedef short bf16x8 __attribute__((ext_vector_type(8)));
typedef float f32x4 __attribute__((ext_vector_type(4)));
typedef float f32x2 __attribute__((ext_vector_type(2)));
typedef unsigned u32x4 __attribute__((ext_vector_type(4)));
typedef unsigned u32x2 __attribute__((ext_vector_type(2)));

constexpr int DM = 1024, NBATCH = 8, SEQ = 2048, DEPTH = 4, CTXL = 256;
constexpr int MMAIN = NBATCH * SEQ, MCTX = NBATCH * CTXL, MALL = MMAIN + MCTX;
constexpr int PROJ_W = 2304, IN_W = 2208, FF = 2816, QCU_W = 384, KVU_W = 512, MODW = 6 * DM;
constexpr float LN_EPS = 1e-6f;
constexpr float DN_ALPHA = 1.6817928305074290f;
constexpr int PC_AK = 0, PC_AV = 128, PC_BK = 256, PC_BV = 512, PC_AQ = 768, PC_BQ = 1024, PC_CQ = 1280, PC_DU = 1536, PC_DV = 1792, PC_CKV = 2048, PC_CKR = 2176;

constexpr size_t MiB = 1u << 20;
constexpr size_t WS_CTL = 0, CTL_ZERO_BYTES = 1 * MiB;
constexpr size_t WS_MOD = 1 * MiB;
constexpr size_t WS_TAB = 2 * MiB;
constexpr size_t WS_W = 3 * MiB, WL_STRIDE = 24 * MiB;
constexpr size_t WO_IN = 0, WO_OUT = 4718592, WO_GU = WO_OUT + 2097152, WO_DN = WO_GU + 11534336, WO_UQ = WO_DN + 5767168, WO_UKV = WO_UQ + 262144, WO_DWS = WO_UKV + 262144;
static_assert(WO_DWS + 131072 <= WL_STRIDE, "weights per layer");
constexpr size_t WS_XC = WS_W + 4 * WL_STRIDE;
constexpr size_t WS_H = WS_XC + 8 * MiB;
constexpr size_t WS_YCAT = WS_H + 36 * MiB;
constexpr size_t WS_PROJ = WS_YCAT + 36 * MiB;
constexpr size_t WS_QCU = WS_PROJ + 81 * MiB;
constexpr size_t WS_KVU = WS_QCU + 14 * MiB;
constexpr size_t WS_ACT = WS_PROJ;
constexpr size_t WS_END = WS_KVU + 18 * MiB;
static_assert((size_t)MALL * FF * 2 <= WS_END - WS_ACT, "ACT overlay");

__device__ __forceinline__ unsigned f2bf(float f) { unsigned u = __builtin_bit_cast(unsigned, f); return (u + 0x7fffu + ((u >> 16) & 1u)) >> 16; }
__device__ __forceinline__ unsigned pk2(float lo, float hi) { return f2bf(lo) | (f2bf(hi) << 16); }
__device__ __forceinline__ float bf2f(bf16_t b) { return __builtin_bit_cast(float, (unsigned)b << 16); }
__device__ __forceinline__ float gelu_tanh(float x) { const float u = 0.7978845608028654f * (x + 0.044715f * x * x * x); const float e = __expf(2.f * u); const float th = 1.f - 2.f / (e + 1.f); return 0.5f * x * (1.f + th); }
__device__ __forceinline__ int perm_c(int p) { return (((p >> 3) ^ (p >> 4)) & 1) ? (p ^ 24) : p; }
__device__ __forceinline__ float wave_sum(float v) {
#pragma unroll
    for (int o = 1; o < 64; o <<= 1) v += __shfl_xor(v, o);
    return v;
}
__device__ __forceinline__ float wave_max(float v) {
#pragma unroll
    for (int o = 1; o < 64; o <<= 1) v = fmaxf(v, __shfl_xor(v, o));
    return v;
}

namespace pg8 {
constexpr int BM = 256, BK = 64, HALF = 128, HTB = HALF * BK * 2, STAGE_BYTES = 8 * HTB, NXCD = 8, WGM = 8;
__host__ __device__ __forceinline__ int lds_byte(int r, int c) { const int st = (r >> 4) * 2 + (c >> 5), rr = r & 15, cc = c & 31, ob = rr * 64 + cc * 2; return st * 1024 + (ob ^ (((ob >> 9) & 1) << 5)); }
__host__ __device__ __forceinline__ void stage_rc(int b, int& R, int& C) { const int st = b / 1024, sb = b % 1024, swz = sb ^ (((sb >> 9) & 1) << 5); R = (st >> 1) * 16 + swz / 64; C = (st & 1) * 32 + (swz % 64) / 2; }
__host__ __device__ __forceinline__ int perm32(int rho) { const int n = rho >> 4, i = rho & 15; return 8 * (i >> 2) + 4 * n + (i & 3); }

struct Unit { int pm, pn; };
struct Gemm { const bf16_t* A; const bf16_t* Bt; int M, N, K, lda; };

struct StaticOrder {
    int nM, nN, nwg, G, c;
    __host__ __device__ void init(int M, int N, int G_, int c_) { nM = M / BM; nN = N / BM; nwg = nM * nN; G = G_; c = c_; }
    __host__ __device__ bool next(int i, Unit& u) const {
        const long L = (long)i * G + c; if (L >= nwg) return false;
        int wgid = (int)L; { const int q = nwg / NXCD, r = nwg % NXCD, xcd = wgid % NXCD, off = wgid / NXCD; wgid = (xcd < r ? xcd * (q + 1) : r * (q + 1) + (xcd - r) * q) + off; }
        const int nig = WGM * nN, gid = wgid / nig, fm = gid * WGM, gsz = (nM - fm) < WGM ? (nM - fm) : WGM;
        u.pm = fm + ((wgid % nig) % gsz); u.pn = (wgid % nig) / gsz; return true;
    }
    __device__ __forceinline__ void a_ready(const Unit&) const {}
    __device__ __forceinline__ void done(const Unit&) const {}
};

__device__ __forceinline__ u32x2 pack4(f32x4 v) { u32x2 w; w.x = pk2(v[0], v[1]); w.y = pk2(v[2], v[3]); return w; }

struct EpiProj {
    static constexpr bool PERM = false, AFTER_DRAIN = false;
    bf16_t* O; int ldc; const float* tabA; const float* tabC;
    __device__ __forceinline__ void operator()(const f32x4 (&acc)[2][2][4][2], const Unit& u, int wr, int wc, int fr, int fq) const {
        const int row0 = u.pm * BM + wr * 64 + fr, col0 = u.pn * BM + wc * 32 + 4 * fq;
        const bool mainrows = u.pm < 64;
#pragma unroll
        for (int ai = 0; ai < 2; ++ai)
#pragma unroll
            for (int m = 0; m < 4; ++m) {
                const int row = row0 + ai * HALF + m * 16, t = row & 2047;
                bf16_t* rowp = O + (size_t)row * ldc + col0;
#pragma unroll
                for (int bj = 0; bj < 2; ++bj) {
                    f32x4 v0 = acc[ai][bj][m][0], v1 = acc[ai][bj][m][1];
                    int mode = 0;
                    if (mainrows) { if ((u.pn == 0 && bj == 0) || u.pn == 3) mode = 1; else if (u.pn == 8 && bj == 1 && wc == 0) mode = 2; }
                    if (mode == 1) {
                        const int pos = (wc & 1) ? (t & 63) : (t >> 6);
                        const f32x4 cs = *(const f32x4*)(tabA + pos * 32 + 4 * fq), sn = *(const f32x4*)(tabA + pos * 32 + 16 + 4 * fq);
                        const f32x4 o0 = v0 * cs - v1 * sn, o1 = v0 * sn + v1 * cs; v0 = o0; v1 = o1;
                    } else if (mode == 2) {
                        const int pos = (fq < 2) ? (t >> 6) : (t & 63);
                        const f32x4 cs = *(const f32x4*)(tabC + pos * 16 + 4 * (fq & 1)), sn = *(const f32x4*)(tabC + pos * 16 + 8 + 4 * (fq & 1));
                        const f32x4 o0 = v0 * cs - v1 * sn, o1 = v0 * sn + v1 * cs; v0 = o0; v1 = o1;
                    }
                    *(u32x2*)(rowp + bj * HALF) = pack4(v0); *(u32x2*)(rowp + bj * HALF + 16) = pack4(v1);
                }
            }
    }
};
struct EpiUp {
    static constexpr bool PERM = false, AFTER_DRAIN = false;
    bf16_t* O; int ldc; int ncols; const LAS float* rs; const float* tabC; int rope;
    __device__ __forceinline__ void operator()(const f32x4 (&acc)[2][2][4][2], const Unit& u, int wr, int wc, int fr, int fq) const {
        const int col0 = u.pn * BM + wc * 32 + 4 * fq;
        const bool dorope = rope && u.pm < 64;
#pragma unroll
        for (int ai = 0; ai < 2; ++ai)
#pragma unroll
            for (int m = 0; m < 4; ++m) {
                const int rloc = ai * HALF + wr * 64 + m * 16 + fr, row = u.pm * BM + rloc, t = row & 2047;
                const float s = rs[rloc];
                const int pos = (fq < 2) ? (t >> 6) : (t & 63);
                f32x4 cs = {1.f, 1.f, 1.f, 1.f}, sn = {0.f, 0.f, 0.f, 0.f};
                if (dorope) { cs = *(const f32x4*)(tabC + pos * 16 + 4 * (fq & 1)); sn = *(const f32x4*)(tabC + pos * 16 + 8 + 4 * (fq & 1)); }
                bf16_t* rowp = O + (size_t)row * ldc + col0;
#pragma unroll
                for (int bj = 0; bj < 2; ++bj) {
                    const int colb = u.pn * BM + bj * HALF + wc * 32;
                    if (colb < ncols) {
                        f32x4 v0 = acc[ai][bj][m][0] * s, v1 = acc[ai][bj][m][1] * s;
                        if (dorope && ((colb >> 5) % 3) == 2) { const f32x4 o0 = v0 * cs - v1 * sn, o1 = v0 * sn + v1 * cs; v0 = o0; v1 = o1; }
                        *(u32x2*)(rowp + bj * HALF) = pack4(v0); *(u32x2*)(rowp + bj * HALF + 16) = pack4(v1);
                    }
                }
                asm volatile("" ::: "memory");
            }
    }
};
struct EpiResid {
    static constexpr bool PERM = false, AFTER_DRAIN = false;
    float* Xmain; float* Xctx; const float* gate;
    __device__ __forceinline__ void operator()(const f32x4 (&acc)[2][2][4][2], const Unit& u, int wr, int wc, int fr, int fq) const {
        const int col0 = u.pn * BM + wc * 32 + 4 * fq;
        const int j = u.pm < 64 ? (u.pm >> 3) : 8;
        float* base = (u.pm < 64 ? Xmain + (size_t)u.pm * BM * DM : Xctx + (size_t)(u.pm - 64) * BM * DM) + col0;
        const float* g = gate + j * MODW + col0;
        f32x4 gv[2][2];
#pragma unroll
        for (int bj = 0; bj < 2; ++bj)
#pragma unroll
            for (int n = 0; n < 2; ++n) gv[bj][n] = *(const f32x4*)(g + bj * HALF + n * 16);
#pragma unroll
        for (int ai = 0; ai < 2; ++ai)
#pragma unroll
            for (int m = 0; m < 4; ++m) { float* rowp = base + (size_t)(ai * HALF + wr * 64 + m * 16 + fr) * DM;
#pragma unroll
                for (int bj = 0; bj < 2; ++bj)
#pragma unroll
                    for (int n = 0; n < 2; ++n) { f32x4 x = *(const f32x4*)(rowp + bj * HALF + n * 16); x = x * DN_ALPHA + gv[bj][n] * acc[ai][bj][m][n]; *(f32x4*)(rowp + bj * HALF + n * 16) = x; } }
    }
};
struct EpiGu {
    static constexpr bool PERM = false, AFTER_DRAIN = false;
    bf16_t* O;
    __device__ __forceinline__ void operator()(const f32x4 (&acc)[2][2][4][2], const Unit& u, int wr, int wc, int fr, int fq) const {
        const int row0 = u.pm * BM + wr * 64 + fr, col0 = u.pn * HALF + wc * 32 + 4 * fq;
#pragma unroll
        for (int ai = 0; ai < 2; ++ai)
#pragma unroll
            for (int m = 0; m < 4; ++m) { bf16_t* rowp = O + (size_t)(row0 + ai * HALF + m * 16) * FF + col0;
#pragma unroll
                for (int n = 0; n < 2; ++n) { const f32x4 g = acc[ai][0][m][n], uu = acc[ai][1][m][n]; f32x4 o;
#pragma unroll
                    for (int e = 0; e < 4; ++e) o[e] = g[e] * __builtin_amdgcn_rcpf(1.f + __builtin_amdgcn_exp2f(-1.4426950408889634f * g[e])) * uu[e];
                    *(u32x2*)(rowp + n * 16) = pack4(o); } }
    }
};

template <class Epi, class Sched, bool ALIGN_EPI = false, bool SP2 = false>
__device__ __forceinline__ void gemm_phase(LAS unsigned char* lds, const Gemm g, const Sched& S, const Epi& E) {
    const int tid = threadIdx.x, wid = __builtin_amdgcn_readfirstlane(tid >> 6), lane = tid & 63, wr = wid >> 2, wc = wid & 3, fr = lane & 15, fq = lane >> 4;
    const int K = g.K, nt = K / BK, lda = g.lda;
    unsigned voffA[2], voffB[2];
#pragma unroll
    for (int i = 0; i < 2; ++i) { int R, C; stage_rc(tid * 16 + i * 8192, R, C); const int Rb = Epi::PERM ? ((R & ~31) + perm32(R & 31)) : R;
        voffA[i] = (unsigned)(R * lda + C) * 2u; voffB[i] = (unsigned)(Rb * K + C) * 2u; }
    const size_t kstep = (size_t)(BK * 2);
    const size_t hsA = (size_t)HALF * lda * 2, hsB = (size_t)HALF * K * 2;
    const size_t tsA = 2 * hsA, tsB = 2 * hsB;
    const unsigned ldsw = (unsigned)wid * 1024u;
    const int aoff = lds_byte(wr * 64 + fr, fq * 8), boff = lds_byte(wc * 32 + fr, fq * 8);
#define PG8_SA(b, h) (((b) * 2 + (h)) * HTB)
#define PG8_SB(b, h) ((4 + (b) * 2 + (h)) * HTB)
#define PG8_STAGE(bufoff, gbase, voff) do { _Pragma("unroll") for (int _i = 0; _i < 2; ++_i) \
        __builtin_amdgcn_global_load_lds((const unsigned*)((const char*)(gbase) + (voff)[_i]), (LAS unsigned*)(lds + (bufoff) + ldsw + _i * 8192), 16, 0, 0); } while (0)
#define PG8_LDA(dst, b, h) do { _Pragma("unroll") for (int m = 0; m < 4; ++m) _Pragma("unroll") for (int k = 0; k < 2; ++k) dst[m][k] = *(const LAS bf16x8*)(lds + PG8_SA(b, h) + aoff + m * 2048 + k * 1024); } while (0)
#define PG8_LDB(dst, b, h) do { _Pragma("unroll") for (int n = 0; n < 2; ++n) _Pragma("unroll") for (int k = 0; k < 2; ++k) dst[n][k] = *(const LAS bf16x8*)(lds + PG8_SB(b, h) + boff + n * 2048 + k * 1024); } while (0)
#define PG8_MMA(ai, bj, At, Bt) do { __builtin_amdgcn_s_setprio(1); _Pragma("unroll") for (int m = 0; m < 4; ++m) _Pragma("unroll") for (int n = 0; n < 2; ++n) _Pragma("unroll") for (int k = 0; k < 2; ++k) \
        acc[ai][bj][m][n] = __builtin_amdgcn_mfma_f32_16x16x32_bf16(Bt[n][k], At[m][k], acc[ai][bj][m][n], 0, 0, 0); __builtin_amdgcn_s_setprio(0); } while (0)
#define PG8_WAIT_V(n) asm volatile("s_waitcnt vmcnt(" #n ")" ::: "memory")
#define PG8_WAIT_L(n) asm volatile("s_waitcnt lgkmcnt(" #n ")" ::: "memory")
#define PG8_BAR __builtin_amdgcn_s_barrier()
#define PG8_SCHED __builtin_amdgcn_sched_barrier(0)
    Unit cur, nxt; int ui = 0;
    if (!S.next(0, cur)) return;
    f32x4 acc[2][2][4][2];
#pragma unroll
    for (int a = 0; a < 2; ++a)
#pragma unroll
        for (int b = 0; b < 2; ++b)
#pragma unroll
            for (int m = 0; m < 4; ++m)
#pragma unroll
                for (int n = 0; n < 2; ++n) acc[a][b][m][n] = (f32x4){0.f, 0.f, 0.f, 0.f};
    bf16x8 At[4][2], B0[2][2], B1[2][2];
    const char* cA = (const char*)g.A + (size_t)cur.pm * tsA; const char* cB = (const char*)g.Bt + (size_t)cur.pn * tsB;
    S.a_ready(cur);
    if constexpr (SP2) {
        PG8_STAGE(PG8_SB(0, 0), cB, voffB); PG8_STAGE(PG8_SB(0, 1), cB + hsB, voffB); PG8_STAGE(PG8_SA(0, 0), cA, voffA); PG8_STAGE(PG8_SA(0, 1), cA + hsA, voffA);
        if (wr == 1) PG8_BAR;
        PG8_WAIT_V(2); PG8_BAR;
        PG8_STAGE(PG8_SB(1, 0), cB + kstep, voffB); PG8_STAGE(PG8_SA(1, 0), cA + kstep, voffA); PG8_STAGE(PG8_SB(1, 1), cB + hsB + kstep, voffB);
        PG8_WAIT_V(6); PG8_BAR;
    } else {
        PG8_STAGE(PG8_SB(0, 0), cB, voffB); PG8_STAGE(PG8_SA(0, 0), cA, voffA); PG8_STAGE(PG8_SB(0, 1), cB + hsB, voffB); PG8_STAGE(PG8_SA(0, 1), cA + hsA, voffA);
        if (wr == 1) PG8_BAR;
        PG8_WAIT_V(4); PG8_BAR;
        PG8_STAGE(PG8_SB(1, 0), cB + kstep, voffB); PG8_STAGE(PG8_SA(1, 0), cA + kstep, voffA); PG8_STAGE(PG8_SB(1, 1), cB + hsB + kstep, voffB);
        PG8_WAIT_V(6); PG8_BAR;
    }
    for (;;) {
        const bool has_next = S.next(ui + 1, nxt);
        const char* nA = has_next ? (const char*)g.A + (size_t)nxt.pm * tsA : cA; const char* nB = has_next ? (const char*)g.Bt + (size_t)nxt.pn * tsB : cB;
        for (int t = 0; t < nt; t += 2) {
            const bool last = (t == nt - 2);
            const char* a1 = cA + (size_t)(t + 1) * kstep;
            const char* a2 = last ? nA : cA + (size_t)(t + 2) * kstep; const char* b2 = last ? nB : cB + (size_t)(t + 2) * kstep;
            const char* a3 = a2 + kstep; const char* b3 = b2 + kstep;
            if (last && has_next) S.a_ready(nxt);
            if constexpr (SP2) {
            PG8_LDB(B0, 0, 0); PG8_LDB(B1, 0, 1); PG8_SCHED; PG8_LDA(At, 0, 0); PG8_STAGE(PG8_SA(1, 1), a1 + hsA, voffA);
            PG8_WAIT_V(8); PG8_WAIT_L(0); PG8_BAR; PG8_MMA(0, 0, At, B0); PG8_MMA(0, 1, At, B1); PG8_BAR; PG8_SCHED;
            PG8_LDA(At, 0, 1); PG8_STAGE(PG8_SB(0, 0), b2, voffB); PG8_STAGE(PG8_SB(0, 1), b2 + hsB, voffB); PG8_STAGE(PG8_SA(0, 0), a2, voffA);
            PG8_WAIT_V(8); PG8_WAIT_L(0); PG8_BAR; PG8_MMA(1, 0, At, B0); PG8_MMA(1, 1, At, B1); PG8_BAR; PG8_SCHED;
            PG8_LDB(B0, 1, 0); PG8_LDB(B1, 1, 1); PG8_SCHED; PG8_LDA(At, 1, 0); PG8_STAGE(PG8_SA(0, 1), a2 + hsA, voffA);
            PG8_WAIT_V(8); PG8_WAIT_L(0); PG8_BAR; PG8_MMA(0, 0, At, B0); PG8_MMA(0, 1, At, B1); PG8_BAR; PG8_SCHED;
            PG8_LDA(At, 1, 1); PG8_STAGE(PG8_SB(1, 0), b3, voffB); PG8_STAGE(PG8_SB(1, 1), b3 + hsB, voffB); PG8_STAGE(PG8_SA(1, 0), a3, voffA);
            PG8_WAIT_V(8); PG8_WAIT_L(0); PG8_BAR; PG8_MMA(1, 0, At, B0); PG8_MMA(1, 1, At, B1); PG8_BAR; PG8_SCHED;
            } else {
            PG8_LDB(B0, 0, 0); PG8_SCHED; PG8_LDA(At, 0, 0); PG8_STAGE(PG8_SA(1, 1), a1 + hsA, voffA);
            PG8_WAIT_L(8); PG8_BAR; PG8_WAIT_L(0); PG8_MMA(0, 0, At, B0); PG8_BAR; PG8_SCHED;
            PG8_LDB(B1, 0, 1); PG8_STAGE(PG8_SB(0, 0), b2, voffB);
            PG8_BAR; PG8_WAIT_L(0); PG8_MMA(0, 1, At, B1); PG8_BAR;
            PG8_LDA(At, 0, 1); PG8_STAGE(PG8_SA(0, 0), a2, voffA);
            PG8_BAR; PG8_WAIT_L(0); PG8_MMA(1, 0, At, B0); PG8_BAR; PG8_SCHED;
            PG8_STAGE(PG8_SB(0, 1), b2 + hsB, voffB);
            PG8_WAIT_V(6); PG8_BAR; PG8_MMA(1, 1, At, B1); PG8_BAR;
            PG8_LDB(B0, 1, 0); PG8_SCHED; PG8_LDA(At, 1, 0); PG8_STAGE(PG8_SA(0, 1), a2 + hsA, voffA);
            PG8_WAIT_L(8); PG8_BAR; PG8_WAIT_L(0); PG8_MMA(0, 0, At, B0); PG8_BAR; PG8_SCHED;
            PG8_LDB(B1, 1, 1); PG8_STAGE(PG8_SB(1, 0), b3, voffB);
            PG8_BAR; PG8_WAIT_L(0); PG8_MMA(0, 1, At, B1); PG8_BAR;
            PG8_LDA(At, 1, 1); PG8_STAGE(PG8_SA(1, 0), a3, voffA);
            PG8_BAR; PG8_WAIT_L(0); PG8_MMA(1, 0, At, B0); PG8_BAR; PG8_SCHED;
            PG8_STAGE(PG8_SB(1, 1), b3 + hsB, voffB);
            PG8_WAIT_V(6); PG8_BAR; PG8_MMA(1, 1, At, B1); PG8_BAR;
            }
        }
        if constexpr (ALIGN_EPI) { if (wr == 0) PG8_BAR; }
        if constexpr (!Epi::AFTER_DRAIN) { E(acc, cur, wr, wc, fr, fq); S.done(cur); }
        if (!has_next) break;
#pragma unroll
        for (int a = 0; a < 2; ++a)
#pragma unroll
            for (int b = 0; b < 2; ++b)
#pragma unroll
                for (int m = 0; m < 4; ++m)
#pragma unroll
                    for (int n = 0; n < 2; ++n) acc[a][b][m][n] = (f32x4){0.f, 0.f, 0.f, 0.f};
        cur = nxt; cA = nA; cB = nB; ++ui;
        if constexpr (ALIGN_EPI) { if (wr == 1) PG8_BAR; }
    }
    PG8_WAIT_V(0);
    if constexpr (!ALIGN_EPI) { if (wr == 0) PG8_BAR; }
    PG8_BAR;
#undef PG8_SA
#undef PG8_SB
#undef PG8_STAGE
#undef PG8_LDA
#undef PG8_LDB
#undef PG8_MMA
#undef PG8_WAIT_V
#undef PG8_WAIT_L
#undef PG8_BAR
#undef PG8_SCHED
}
}

typedef GAS unsigned gu32;
#define RLX_AGENT __ATOMIC_RELAXED, __HIP_MEMORY_SCOPE_AGENT
#define XB_TMO      128
#define XB_XCNT(j)  (256  + 64 * (j))
#define XB_XSUB(j)  (1280 + 64 * (j))
#define XB_XGEN(j)  (2304 + 64 * (j))
#define XB_TOP      3328
#define XB_TOPGEN   3392
#define XCD_BAR_WORDS 3456
#define XB_SPIN_CAP (1u << 18)
__device__ __forceinline__ unsigned xb_ld(unsigned* p)              { return __hip_atomic_load(p, __ATOMIC_RELAXED, __HIP_MEMORY_SCOPE_AGENT); }
__device__ __forceinline__ unsigned xb_add(unsigned* p, unsigned v) { return __hip_atomic_fetch_add(p, v, __ATOMIC_RELAXED, __HIP_MEMORY_SCOPE_AGENT); }
__device__ __forceinline__ unsigned xb_xcc_id() { return (unsigned)__builtin_amdgcn_s_getreg((3 << 11) | 20) & 0xFu; }
#define XB_SPIN(cond, bar) do { unsigned _sp = 0; while (cond) { __builtin_amdgcn_s_sleep(1); \
    if ((++_sp & 255u) == 0u) { if (xb_ld(&(bar)[XB_TMO])) break; if (_sp > XB_SPIN_CAP) { atomicAdd(&(bar)[XB_TMO], 1u); break; } } } } while (0)
struct XcdBarrier { unsigned* bar; unsigned x; volatile LAS unsigned* st; };
__device__ __forceinline__ XcdBarrier xcd_barrier_post(unsigned* bar, volatile LAS unsigned* st) {
    XcdBarrier b; b.bar = bar; b.x = xb_xcc_id(); b.st = st;
    if (threadIdx.x == 0) (void)xb_add(&bar[XB_XCNT(b.x)], 1u);
    return b;
}
__device__ __forceinline__ void xcd_barrier_complete(unsigned* bar, unsigned x, unsigned& nloc, unsigned& nx) {
    const unsigned G = gridDim.x * gridDim.y * gridDim.z;
    unsigned sum, cnt, mine, sp = 0u;
    for (;;) {
        sum = 0u; cnt = 0u; mine = 0u;
#pragma unroll
        for (unsigned j = 0; j < 16; ++j) { const unsigned c = xb_ld(&bar[XB_XCNT(j)]); sum += c; cnt += (c > 0u) ? 1u : 0u; mine = (j == x) ? c : mine; }
        if (sum == G) break;
        __builtin_amdgcn_s_sleep(1);
        if ((++sp & 255u) == 0u) { if (xb_ld(&bar[XB_TMO])) break; if (sp > XB_SPIN_CAP) { atomicAdd(&bar[XB_TMO], 1u); break; } }
    }
    nloc = mine > 0u ? mine : 1u; nx = cnt > 0u ? cnt : 1u;
}
__device__ __forceinline__ void xcd_barrier(const XcdBarrier& b) {
    asm volatile("s_waitcnt vmcnt(0)" ::: "memory");
    __syncthreads();
    if (threadIdx.x == 0) {
        unsigned* bar = b.bar;
        __builtin_amdgcn_s_waitcnt(0);
        unsigned nloc = b.st[0], nx = b.st[1];
        if (nloc == 0u) { xcd_barrier_complete(bar, b.x, nloc, nx); b.st[0] = nloc; b.st[1] = nx; }
        const unsigned old = xb_add(&bar[XB_XSUB(b.x)], 1u);
        const unsigned gen = old / nloc;
        if (old + 1u == (gen + 1u) * nloc) {
            __builtin_amdgcn_fence(__ATOMIC_RELEASE, "agent");
            asm volatile("s_waitcnt vmcnt(0)" ::: "memory");
            const unsigned og = xb_add(&bar[XB_TOP], 1u);
            const unsigned tg = og / nx;
            if (og + 1u == (tg + 1u) * nx) xb_add(&bar[XB_TOPGEN], 1u);
            else XB_SPIN(xb_ld(&bar[XB_TOPGEN]) == tg, bar);
            __builtin_amdgcn_fence(__ATOMIC_ACQUIRE, "agent");
            xb_add(&bar[XB_XGEN(b.x)], 1u);
            asm volatile("s_waitcnt vmcnt(0)" ::: "memory");
        } else {
            XB_SPIN(xb_ld(&bar[XB_XGEN(b.x)]) == gen, bar);
            __builtin_amdgcn_fence(__ATOMIC_ACQUIRE, "agent");
            asm volatile("s_waitcnt vmcnt(0)" ::: "memory");
        }
    }
    __syncthreads();
}

constexpr int NWAVES = 8, NTHR = 512;
constexpr int RING_BYTES = 131072, TABL_OFF = RING_BYTES  , LDSCTL_OFF = RING_BYTES + 1024, LDS_BYTES = 147456;
constexpr int CW_BAR = 4096;

struct Args { const float* in[24]; float* out; unsigned char* ws; int ph_lo, ph_hi, use_bar, pad; };
enum { I_X = 0, I_C, I_CTX, I_CCTX, I_WMOD, I_BMOD, I_WIN, I_ASINK, I_BRPB, I_CQN, I_CKVN, I_WUQ, I_WUKV, I_DLNG, I_DLNB, I_DWS, I_DBS, I_WOUT, I_LN1G, I_LN1B, I_WGU, I_WDN, I_LN2G, I_LN2B };

struct Frame {
    LAS unsigned char* lds; int tid, lane, wave, G, bid;
    const float* const* in; float* out; unsigned char* ws;
};
__device__ __forceinline__ bf16_t* wl(const Frame& F, int l, size_t off) { return (bf16_t*)(F.ws + WS_W + (size_t)l * WL_STRIDE + off); }

template <int MAP> __device__ __forceinline__ int rowmap(int n) {
    if (MAP == 1) {
        if (n < 768) return n;
        if (n < 896) return PC_CKV + (n - 768);
        if (n < 928) return PC_CKR + perm_c(n - 896);
        if (n < 1184) return PC_AQ + (n - 928);
        if (n < 1440) return PC_BQ + (n - 1184);
        if (n < 1696) return PC_CQ + (n - 1440);
        if (n < 1952) return PC_DU + (n - 1696);
        return PC_DV + (n - 1952);
    }
    if (MAP == 2) { if (n < FF) return (n >> 7) * 256 + (n & 127); const int i = n - FF; return (i >> 7) * 256 + 128 + (i & 127); }
    if (MAP == 3) { const int h = n / 96, e = n % 96; return e < 64 ? n : h * 96 + 64 + perm_c(e - 64); }
    return n;
}
template <int MAP> __device__ __forceinline__ void transpose_item(const float* W, int K, int N, bf16_t* WT, int ldk, const float* kscale, LAS float* scr, int item, int lane) {
    const int nblk = N / 32, kb = item / nblk, nb = item % nblk, k0 = 64 * kb, n0 = 32 * nb;
#pragma unroll 8
    for (int i = 0; i < 32; ++i) { const int kk = 2 * i + (lane >> 5); float v = W[(size_t)(k0 + kk) * N + n0 + (lane & 31)]; if (kscale) v *= kscale[k0 + kk]; scr[kk * 33 + (lane & 31)] = v; }
    asm volatile("s_waitcnt lgkmcnt(0)" ::: "memory");
    const int c = lane & 7;
#pragma unroll
    for (int j = 0; j < 4; ++j) { const int n = (lane >> 3) + 8 * j; const LAS float* s = scr + (8 * c) * 33 + n;
        u32x4 o; o.x = pk2(s[0 * 33], s[1 * 33]); o.y = pk2(s[2 * 33], s[3 * 33]); o.z = pk2(s[4 * 33], s[5 * 33]); o.w = pk2(s[6 * 33], s[7 * 33]);
        *(u32x4*)(WT + (size_t)rowmap<MAP>(n0 + n) * ldk + k0 + 8 * c) = o; }
    asm volatile("s_waitcnt lgkmcnt(0)" ::: "memory");
}
__device__ __forceinline__ void phase_prologue0(Frame& F) {
    LAS float* sv = (LAS float*)(F.lds);
    LAS float* red = (LAS float*)(F.lds + 36864);
    for (int i = F.tid; i < 9 * 1024; i += NTHR) { const int j = i >> 10, k = i & 1023; const float v = j < 8 ? F.in[I_C][j * 1024 + k] : F.in[I_CCTX][k]; sv[i] = v / (1.f + __expf(-v)); }
    __syncthreads();
    for (int u = F.bid; u < DEPTH * (MODW / 64); u += F.G) {
        const int l = u / (MODW / 64), c0 = (u % (MODW / 64)) * 64;
        const float* W = F.in[I_WMOD] + (size_t)l * DM * MODW + c0 + F.lane;
        float a[9];
#pragma unroll
        for (int j = 0; j < 9; ++j) a[j] = 0.f;
        const int kb = F.wave * 128;
#pragma unroll 4
        for (int k = 0; k < 128; ++k) { const float w = W[(size_t)(kb + k) * MODW];
#pragma unroll
            for (int j = 0; j < 9; ++j) a[j] += sv[j * 1024 + kb + k] * w; }
#pragma unroll
        for (int j = 0; j < 9; ++j) red[(F.wave * 9 + j) * 64 + F.lane] = a[j];
        __syncthreads();
        for (int i = F.tid; i < 9 * 64; i += NTHR) { const int j = i >> 6, c = i & 63; float s = 0.f;
#pragma unroll
            for (int w = 0; w < 8; ++w) s += red[(w * 9 + j) * 64 + c];
            ((float*)(F.ws + WS_MOD))[((size_t)l * 9 + j) * MODW + c0 + c] = s + F.in[I_BMOD][l * MODW + c0 + c]; }
        __syncthreads();
    }
    __syncthreads();
    LAS float* scr = (LAS float*)(F.lds + F.wave * 16384);
    const int gw = F.bid * NWAVES + F.wave, NGW = F.G * NWAVES;
    constexpr int I_IN = 16 * (IN_W / 32), I_OUT = 16 * 32, I_GU = 16 * (2 * FF / 32), I_DN = (FF / 64) * 32, I_UQ = 4 * (QCU_W / 32), I_UKV = 2 * (KVU_W / 32);
    constexpr int PER_L = I_IN + I_OUT + I_GU + I_DN + I_UQ + I_UKV;
    for (int it = gw; it < DEPTH * PER_L; it += NGW) {
        const int l = it / PER_L; int r = it % PER_L;
        if (r < I_IN) { transpose_item<1>(F.in[I_WIN] + (size_t)l * DM * IN_W, DM, IN_W, wl(F, l, WO_IN), DM, nullptr, scr, r, F.lane); continue; } r -= I_IN;
        if (r < I_OUT) { transpose_item<0>(F.in[I_WOUT] + (size_t)l * DM * DM, DM, DM, wl(F, l, WO_OUT), DM, nullptr, scr, r, F.lane); continue; } r -= I_OUT;
        if (r < I_GU) { transpose_item<2>(F.in[I_WGU] + (size_t)l * DM * 2 * FF, DM, 2 * FF, wl(F, l, WO_GU), DM, nullptr, scr, r, F.lane); continue; } r -= I_GU;
        if (r < I_DN) { transpose_item<0>(F.in[I_WDN] + (size_t)l * FF * DM, FF, DM, wl(F, l, WO_DN), FF, nullptr, scr, r, F.lane); continue; } r -= I_DN;
        if (r < I_UQ) { transpose_item<3>(F.in[I_WUQ] + (size_t)l * 256 * QCU_W, 256, QCU_W, wl(F, l, WO_UQ), 256, F.in[I_CQN] + l * 256, scr, r, F.lane); continue; } r -= I_UQ;
        transpose_item<0>(F.in[I_WUKV] + (size_t)l * 128 * KVU_W, 128, KVU_W, wl(F, l, WO_UKV), 256, F.in[I_CKVN] + l * 128, scr, r, F.lane);
    }
    {
        constexpr int Z_IN = 96 * DM / 8, Z_UQ = 128 * 256 / 8, Z_UKV = 512 * 128 / 8, Z_L = Z_IN + Z_UQ + Z_UKV;
        const int gt = F.bid * NTHR + F.tid, NGT = F.G * NTHR; const u32x4 z = {0u, 0u, 0u, 0u};
        for (int i = gt; i < DEPTH * Z_L; i += NGT) { const int l = i / Z_L; int r = i % Z_L;
            if (r < Z_IN) { *(u32x4*)(wl(F, l, WO_IN) + (size_t)IN_W * DM + (size_t)r * 8) = z; continue; } r -= Z_IN;
            if (r < Z_UQ) { *(u32x4*)(wl(F, l, WO_UQ) + (size_t)QCU_W * 256 + (size_t)r * 8) = z; continue; } r -= Z_UQ;
            const int row = r >> 4, c8 = r & 15; *(u32x4*)(wl(F, l, WO_UKV) + (size_t)row * 256 + 128 + c8 * 8) = z; }
        for (int i = gt; i < DEPTH * 65536; i += NGT) { const int l = i >> 16, e = i & 65535; wl(F, l, WO_DWS)[e] = (bf16_t)f2bf(F.in[I_DWS][i]); }
        float* tabA = (float*)(F.ws + WS_TAB); float* tabC = tabA + 2048;
        for (int i = gt; i < 64 * 16; i += NGT) { const int pos = i >> 4, k = i & 15; const float inv = powf(10000.f, -(float)k / 16.f), ang = (float)pos * inv; tabA[pos * 32 + k] = cosf(ang); tabA[pos * 32 + 16 + k] = sinf(ang); }
        for (int i = gt; i < 64 * 8; i += NGT) { const int pos = i >> 3, k = i & 7; const float inv = powf(10000.f, -(float)k / 8.f), ang = (float)pos * inv; tabC[pos * 16 + k] = cosf(ang); tabC[pos * 16 + 8 + k] = sinf(ang); }
    }
}
__device__ __forceinline__ void store_h_row(bf16_t* hrow, const f32x4 (&v)[4], const float* sh, const float* sc, int lane) {
#pragma unroll
    for (int j = 0; j < 4; ++j) { const int c = 4 * lane + 256 * j; const f32x4 s = *(const f32x4*)(sc + c), b = *(const f32x4*)(sh + c); const f32x4 h = v[j] * (s + 1.f) + b;
        *(u32x2*)(hrow + c) = pg8::pack4(h); }
}
__device__ __forceinline__ void phase_prologue1(Frame& F) {
    const int gw = F.bid * NWAVES + F.wave, NGW = F.G * NWAVES;
    const float* mod = (const float*)(F.ws + WS_MOD);
    bf16_t* H = (bf16_t*)(F.ws + WS_H); float* XC = (float*)(F.ws + WS_XC);
    for (int r = gw; r < MALL; r += NGW) {
        const bool mainr = r < MMAIN; const int j = mainr ? (r >> 11) : 8;
        const float* src = mainr ? F.in[I_X] + (size_t)r * DM : F.in[I_CTX] + (size_t)(r - MMAIN) * DM;
        float* dst = mainr ? F.out + (size_t)r * DM : XC + (size_t)(r - MMAIN) * DM;
        f32x4 v[4];
#pragma unroll
        for (int jj = 0; jj < 4; ++jj) { v[jj] = *(const f32x4*)(src + 4 * F.lane + 256 * jj); *(f32x4*)(dst + 4 * F.lane + 256 * jj) = v[jj]; }
        store_h_row(H + (size_t)r * DM, v, mod + (size_t)j * MODW, mod + (size_t)j * MODW + DM, F.lane);
    }
}
__device__ __forceinline__ void phase_ln(Frame& F, int mrows, const float* g, const float* b, const float* modl  , int sh_chunk, int sc_chunk) {
    const int gw = F.bid * NWAVES + F.wave, NGW = F.G * NWAVES;
    bf16_t* H = (bf16_t*)(F.ws + WS_H); float* XC = (float*)(F.ws + WS_XC);
    for (int r = gw; r < mrows; r += NGW) {
        const bool mainr = r < MMAIN; const int j = mainr ? (r >> 11) : 8;
        float* xr = mainr ? F.out + (size_t)r * DM : XC + (size_t)(r - MMAIN) * DM;
        f32x4 v[4]; float s = 0.f;
#pragma unroll
        for (int jj = 0; jj < 4; ++jj) { v[jj] = *(const f32x4*)(xr + 4 * F.lane + 256 * jj); s += (v[jj][0] + v[jj][1]) + (v[jj][2] + v[jj][3]); }
        const float mean = wave_sum(s) * (1.f / DM); float s2 = 0.f;
#pragma unroll
        for (int jj = 0; jj < 4; ++jj) { v[jj] = v[jj] - mean; s2 += (v[jj][0] * v[jj][0] + v[jj][1] * v[jj][1]) + (v[jj][2] * v[jj][2] + v[jj][3] * v[jj][3]); }
        const float rstd = 1.f / sqrtf(wave_sum(s2) * (1.f / DM) + LN_EPS);
#pragma unroll
        for (int jj = 0; jj < 4; ++jj) { const int c = 4 * F.lane + 256 * jj; v[jj] = v[jj] * rstd * *(const f32x4*)(g + c) + *(const f32x4*)(b + c); *(f32x4*)(xr + c) = v[jj]; }
        if (modl) store_h_row(H + (size_t)r * DM, v, modl + (size_t)j * MODW + sh_chunk * DM, modl + (size_t)j * MODW + sc_chunk * DM, F.lane);
    }
}

struct KSrc { const bf16_t* k1; int k1ld; const bf16_t* k2; int k2ld; const bf16_t* v; int vld; };
template <class KeyFn> __device__ __forceinline__ void naive_attn_row(const bf16_t* q, int nkeys, const KSrc& ks, KeyFn kf, bool has_sink, float sink, float scale, bf16_t* out,
                                                                        LAS float* sc, LAS unsigned short* rowi, LAS float* qf, int lane) {
    const int dqk = ks.k2 ? 96 : 64;
    for (int d = lane; d < dqk; d += 64) qf[d] = bf2f(q[d]);
    asm volatile("s_waitcnt lgkmcnt(0)" ::: "memory");
    float mx = has_sink ? sink : -1e30f;
    for (int kk = lane; kk < nkeys; kk += 64) {
        int row; float bias; kf(kk, row, bias);
        float dot = 0.f;
        const bf16_t* kp = ks.k1 + (size_t)row * ks.k1ld;
#pragma unroll
        for (int c = 0; c < 8; ++c) { const u32x4 w = *(const u32x4*)(kp + 8 * c);
#pragma unroll
            for (int e = 0; e < 4; ++e) { dot += qf[8 * c + 2 * e] * __builtin_bit_cast(float, w[e] << 16) + qf[8 * c + 2 * e + 1] * __builtin_bit_cast(float, w[e] & 0xffff0000u); } }
        if (ks.k2) { const bf16_t* kp2 = ks.k2 + (size_t)row * ks.k2ld;
#pragma unroll
            for (int c = 0; c < 4; ++c) { const u32x4 w = *(const u32x4*)(kp2 + 8 * c);
#pragma unroll
                for (int e = 0; e < 4; ++e) { dot += qf[64 + 8 * c + 2 * e] * __builtin_bit_cast(float, w[e] << 16) + qf[64 + 8 * c + 2 * e + 1] * __builtin_bit_cast(float, w[e] & 0xffff0000u); } } }
        const float s = dot * scale + bias;
        sc[kk] = s; rowi[kk] = (unsigned short)row; mx = fmaxf(mx, s);
    }
    mx = wave_max(mx);
    float sum = 0.f;
    for (int kk = lane; kk < nkeys; kk += 64) { const float p = __expf(sc[kk] - mx); sc[kk] = p; sum += p; }
    sum = wave_sum(sum); if (has_sink) sum += __expf(sink - mx);
    asm volatile("s_waitcnt lgkmcnt(0)" ::: "memory");
    float a0 = 0.f, a1 = 0.f, a2 = 0.f, a3 = 0.f;
    const bf16_t* vb = ks.v + lane;
    int kk = 0;
    for (; kk + 4 <= nkeys; kk += 4) {
        a0 += sc[kk] * bf2f(vb[(size_t)rowi[kk] * ks.vld]); a1 += sc[kk + 1] * bf2f(vb[(size_t)rowi[kk + 1] * ks.vld]);
        a2 += sc[kk + 2] * bf2f(vb[(size_t)rowi[kk + 2] * ks.vld]); a3 += sc[kk + 3] * bf2f(vb[(size_t)rowi[kk + 3] * ks.vld]);
    }
    for (; kk < nkeys; ++kk) a0 += sc[kk] * bf2f(vb[(size_t)rowi[kk] * ks.vld]);
    out[lane] = (bf16_t)f2bf(((a0 + a1) + (a2 + a3)) / sum);
    asm volatile("s_waitcnt lgkmcnt(0)" ::: "memory");
}
__device__ __forceinline__ void phase_naive_ab(Frame& F, int l, bool last) {
    const bf16_t* PROJ = (const bf16_t*)(F.ws + WS_PROJ); bf16_t* YC = (bf16_t*)(F.ws + WS_YCAT);
    LAS float* sc = (LAS float*)(F.lds + F.wave * 16384); LAS unsigned short* rowi = (LAS unsigned short*)(F.lds + F.wave * 16384 + 4096); LAS float* qf = (LAS float*)(F.lds + F.wave * 16384 + 8192);
    const int gw = F.bid * NWAVES + F.wave, NGW = F.G * NWAVES;
    const int mrows = last ? MMAIN : MALL;
    for (int task = gw; task < mrows * 4; task += NGW) {
        const int r = task >> 2, hq = task & 3, hkv = hq >> 1;
        const float sink = F.in[I_ASINK][l * 4 + hq];
        KSrc ks{PROJ + PC_AK + 64 * hkv, PROJ_W, nullptr, 0, PROJ + PC_AV + 64 * hkv, PROJ_W};
        const bf16_t* q = PROJ + (size_t)r * PROJ_W + PC_AQ + 64 * hq; bf16_t* o = YC + (size_t)r * DM + 64 * hq;
        if (r < MMAIN) {
            const int b = r >> 11, t = r & 2047, lo = t - 128 < 0 ? 0 : t - 128, hi = t + 128 > 2047 ? 2047 : t + 128, nloc = hi - lo + 1;
            auto kf = [&](int kk, int& row, float& bias) { bias = 0.f; row = kk < nloc ? b * SEQ + lo + kk : MMAIN + b * CTXL + (kk - nloc); };
            naive_attn_row(q, nloc + CTXL, ks, kf, true, sink, 0.125f, o, sc, rowi, qf, F.lane);
        } else {
            const int b = (r - MMAIN) >> 8;
            auto kf = [&](int kk, int& row, float& bias) { bias = 0.f; row = MMAIN + b * CTXL + kk; };
            naive_attn_row(q, CTXL, ks, kf, true, sink, 0.125f, o, sc, rowi, qf, F.lane);
        }
    }
    const float* rpb = F.in[I_BRPB] + (size_t)l * 4 * 15 * 31;
    for (int task = gw; task < mrows * 4; task += NGW) {
        const int r = task >> 2, h = task & 3;
        KSrc ks{PROJ + PC_BK + 64 * h, PROJ_W, nullptr, 0, PROJ + PC_BV + 64 * h, PROJ_W};
        const bf16_t* q = PROJ + (size_t)r * PROJ_W + PC_BQ + 64 * h; bf16_t* o = YC + (size_t)r * DM + 256 + 64 * h;
        if (r < MMAIN) {
            const int b = r >> 11, t = r & 2047, gr = t >> 6, gc = t & 63;
            const int rs = gr - 4 < 0 ? 0 : (gr - 4 > 24 ? 24 : gr - 4), cs = gc - 8 < 0 ? 0 : (gc - 8 > 48 ? 48 : gc - 8);
            auto kf = [&](int kk, int& row, float& bias) {
                if (kk < 128) { const int jr = kk >> 4, kc = cs + (kk & 15), kr = rs + jr; row = b * SEQ + kr * 64 + kc; bias = rpb[(h * 15 + (kr - gr + 7)) * 31 + (kc - gc + 15)]; }
                else { row = MMAIN + b * CTXL + (kk - 128); bias = 0.f; } };
            naive_attn_row(q, 128 + CTXL, ks, kf, false, 0.f, 0.125f, o, sc, rowi, qf, F.lane);
        } else {
            const int b = (r - MMAIN) >> 8;
            auto kf = [&](int kk, int& row, float& bias) { bias = 0.f; row = MMAIN + b * CTXL + kk; };
            naive_attn_row(q, CTXL, ks, kf, false, 0.f, 0.125f, o, sc, rowi, qf, F.lane);
        }
    }
}
__device__ __forceinline__ void phase_naive_c(Frame& F, int l, bool last) {
    const bf16_t* PROJ = (const bf16_t*)(F.ws + WS_PROJ); const bf16_t* QCU = (const bf16_t*)(F.ws + WS_QCU); const bf16_t* KVU = (const bf16_t*)(F.ws + WS_KVU); bf16_t* YC = (bf16_t*)(F.ws + WS_YCAT);
    LAS float* sc = (LAS float*)(F.lds + F.wave * 16384); LAS unsigned short* rowi = (LAS unsigned short*)(F.lds + F.wave * 16384 + 9216); LAS float* qf = (LAS float*)(F.lds + F.wave * 16384 + 13824);
    const int gw = F.bid * NWAVES + F.wave, NGW = F.G * NWAVES;
    const int mrows = last ? MMAIN : MALL;
    const float scale = 0.10206207261596575f;
    for (int task = gw; task < mrows * 4; task += NGW) {
        const int r = task >> 2, h = task & 3;
        KSrc ks{KVU + 128 * h, KVU_W, PROJ + PC_CKR, PROJ_W, KVU + 128 * h + 64, KVU_W};
        const bf16_t* q = QCU + (size_t)r * QCU_W + 96 * h; bf16_t* o = YC + (size_t)r * DM + 512 + 64 * h;
        if (r < MMAIN) {
            const int b = r >> 11;
            auto kf = [&](int kk, int& row, float& bias) { bias = 0.f; row = kk < CTXL ? MMAIN + b * CTXL + kk : b * SEQ + (kk - CTXL); };
            naive_attn_row(q, CTXL + SEQ, ks, kf, false, 0.f, scale, o, sc, rowi, qf, F.lane);
        } else {
            const int b = (r - MMAIN) >> 8;
            auto kf = [&](int kk, int& row, float& bias) { bias = 0.f; row = MMAIN + b * CTXL + kk; };
            naive_attn_row(q, CTXL, ks, kf, false, 0.f, scale, o, sc, rowi, qf, F.lane);
        }
    }
}
__device__ __forceinline__ void phase_naive_d(Frame& F, int l, bool last) {
    const bf16_t* PROJ = (const bf16_t*)(F.ws + WS_PROJ); bf16_t* YC = (bf16_t*)(F.ws + WS_YCAT);
    LAS float* vln = (LAS float*)(F.lds);
    const float* lg = F.in[I_DLNG] + l * 256; const float* lb = F.in[I_DLNB] + l * 256;
    const float* ws = F.in[I_DWS] + (size_t)l * 4 * 128 * 128; const float* bs = F.in[I_DBS] + l * 4 * 128;
    const int nchunk = (last ? MMAIN : MALL) / 128;
    for (int ch = F.bid; ch < nchunk; ch += F.G) {
        __syncthreads();
        for (int i = 0; i < 16; ++i) { const int rl = F.wave * 16 + i; const bf16_t* p = PROJ + (size_t)(ch * 128 + rl) * PROJ_W + PC_DV + 4 * F.lane;
            const u32x2 w = *(const u32x2*)p; float x[4] = {__builtin_bit_cast(float, w.x << 16), __builtin_bit_cast(float, w.x & 0xffff0000u), __builtin_bit_cast(float, w.y << 16), __builtin_bit_cast(float, w.y & 0xffff0000u)};
            float s = 0.f;
#pragma unroll
            for (int e = 0; e < 4; ++e) { x[e] = gelu_tanh(x[e]); s += x[e]; }
            const float mean = wave_sum(s) * (1.f / 256.f); float s2 = 0.f;
#pragma unroll
            for (int e = 0; e < 4; ++e) { x[e] -= mean; s2 += x[e] * x[e]; }
            const float rstd = 1.f / sqrtf(wave_sum(s2) * (1.f / 256.f) + LN_EPS);
#pragma unroll
            for (int e = 0; e < 4; ++e) vln[rl * 256 + 4 * F.lane + e] = x[e] * rstd * lg[4 * F.lane + e] + lb[4 * F.lane + e]; }
        __syncthreads();
        const int chn = F.tid & 255, g = chn >> 6, t0 = (F.tid >> 8) * 64;
        for (int t = t0; t < t0 + 64; ++t) { const float* wr = ws + ((size_t)g * 128 + t) * 128; float a0 = 0.f, a1 = 0.f;
#pragma unroll 8
            for (int s = 0; s < 128; s += 2) { a0 += wr[s] * vln[s * 256 + chn]; a1 += wr[s + 1] * vln[(s + 1) * 256 + chn]; }
            const float mixed = a0 + a1 + bs[g * 128 + t];
            const size_t row = (size_t)ch * 128 + t; const float u = gelu_tanh(bf2f(PROJ[row * PROJ_W + PC_DU + chn]));
            YC[row * DM + 768 + chn] = (bf16_t)f2bf(u * mixed); }
    }
    __syncthreads();
}
__device__ __forceinline__ void phase_naive_up(Frame& F, int l, bool last) {
    const bf16_t* PROJ = (const bf16_t*)(F.ws + WS_PROJ); bf16_t* QCU = (bf16_t*)(F.ws + WS_QCU); bf16_t* KVU = (bf16_t*)(F.ws + WS_KVU);
    const float* tabC = (const float*)(F.ws + WS_TAB) + 2048;
    LAS float* av = (LAS float*)(F.lds + F.wave * 16384);
    LAS float* ov = (LAS float*)(F.lds + F.wave * 16384 + 2048);
    const int gw = F.bid * NWAVES + F.wave, NGW = F.G * NWAVES;
    const float* wq = F.in[I_WUQ] + (size_t)l * 256 * QCU_W; const float* wkv = F.in[I_WUKV] + (size_t)l * 128 * KVU_W;
    const float* gq = F.in[I_CQN] + l * 256; const float* gkv = F.in[I_CKVN] + l * 128;
    for (int r = gw; r < MALL; r += NGW) {
        const int t = r & 2047; const bool mainr = r < MMAIN;
        if (!(last && !mainr)) {
            float ss = 0.f; float x[4];
#pragma unroll
            for (int j = 0; j < 4; ++j) { x[j] = bf2f(PROJ[(size_t)r * PROJ_W + PC_CQ + F.lane + 64 * j]); ss += x[j] * x[j]; }
            const float rstd = 1.f / sqrtf(wave_sum(ss) * (1.f / 256.f) + LN_EPS);
#pragma unroll
            for (int j = 0; j < 4; ++j) av[F.lane + 64 * j] = x[j] * rstd * gq[F.lane + 64 * j];
            asm volatile("s_waitcnt lgkmcnt(0)" ::: "memory");
            float o[6] = {0.f, 0.f, 0.f, 0.f, 0.f, 0.f};
            for (int k = 0; k < 256; ++k) { const float a = av[k];
#pragma unroll
                for (int j = 0; j < 6; ++j) o[j] += a * wq[(size_t)k * QCU_W + F.lane + 64 * j]; }
#pragma unroll
            for (int j = 0; j < 6; ++j) ov[F.lane + 64 * j] = o[j];
            asm volatile("s_waitcnt lgkmcnt(0)" ::: "memory");
#pragma unroll
            for (int j = 0; j < 6; ++j) { const int n = F.lane + 64 * j, h = n / 96, e = n % 96; float val;
                if (e < 64) val = ov[n];
                else { const int p = e - 64, d = perm_c(p);
                    const float xv = ov[h * 96 + 64 + d];
                    if (!mainr) val = xv;
                    else { const int hf = d >> 4, i = d & 7, second = (d >> 3) & 1;
                        const int pos = hf ? (t & 63) : (t >> 6); const float cs = tabC[pos * 16 + i], sn = tabC[pos * 16 + 8 + i];
                        const float other = ov[h * 96 + 64 + (d ^ 8)];
                        val = second ? (other * sn + xv * cs) : (xv * cs - other * sn); } }
                QCU[(size_t)r * QCU_W + n] = (bf16_t)f2bf(val); }
            asm volatile("s_waitcnt lgkmcnt(0)" ::: "memory");
        }
        {
            float ss = 0.f; float x[2];
#pragma unroll
            for (int j = 0; j < 2; ++j) { x[j] = bf2f(PROJ[(size_t)r * PROJ_W + PC_CKV + F.lane + 64 * j]); ss += x[j] * x[j]; }
            const float rstd = 1.f / sqrtf(wave_sum(ss) * (1.f / 128.f) + LN_EPS);
#pragma unroll
            for (int j = 0; j < 2; ++j) av[F.lane + 64 * j] = x[j] * rstd * gkv[F.lane + 64 * j];
            asm volatile("s_waitcnt lgkmcnt(0)" ::: "memory");
            float o[8] = {0.f, 0.f, 0.f, 0.f, 0.f, 0.f, 0.f, 0.f};
            for (int k = 0; k < 128; ++k) { const float a = av[k];
#pragma unroll
                for (int j = 0; j < 8; ++j) o[j] += a * wkv[(size_t)k * KVU_W + F.lane + 64 * j]; }
#pragma unroll
            for (int j = 0; j < 8; ++j) KVU[(size_t)r * KVU_W + F.lane + 64 * j] = (bf16_t)f2bf(o[j]);
            asm volatile("s_waitcnt lgkmcnt(0)" ::: "memory");
        }
    }
}
__device__ __forceinline__ void unit_rstd(Frame& F, const pg8::StaticOrder& S, const bf16_t* A, int lda, int ncol) {
    pg8::Unit u; LAS float* rs = (LAS float*)(F.lds + TABL_OFF);
    __syncthreads();
    if (S.next(0, u)) {
        const int r = F.tid >> 1, hf = F.tid & 1, n8 = ncol / 16;
        const bf16_t* p = A + (size_t)(u.pm * 256 + r) * lda + hf * (ncol / 2); float s = 0.f;
        for (int c = 0; c < n8; ++c) { const u32x4 w = *(const u32x4*)(p + 8 * c);
#pragma unroll
            for (int e = 0; e < 4; ++e) { const float a = __builtin_bit_cast(float, w[e] << 16), b = __builtin_bit_cast(float, w[e] & 0xffff0000u); s += a * a + b * b; } }
        s += __shfl_xor(s, 1);
        if (hf == 0) rs[r] = 1.f / sqrtf(s / (float)ncol + LN_EPS);
    }
    __syncthreads();
}

constexpr int NPHASE = 2 + 8 * DEPTH;
#define IN(k) (lo <= (k) && (k) < hi)
#define SEAM(k) do { if (use_bar && (k) + 1 < hi) xcd_barrier(bar); } while (0)
#define FRESH() asm volatile("" : "+s"(F.ws), "+s"(F.out), "+s"(F.bid), "+s"(F.G))
template <int l> __device__ __forceinline__ void layer_phases(Frame& F, const XcdBarrier& bar, const int lo, const int hi, const int use_bar) {
    constexpr int p0 = 2 + 8 * l;
        if (IN(p0 + 0)) {
            FRESH();
            pg8::Gemm g{(const bf16_t*)(F.ws + WS_H), wl(F, l, WO_IN), MALL, PROJ_W, DM, DM}; pg8::StaticOrder S; S.init(MALL, PROJ_W, F.G, F.bid);
            pg8::EpiProj E{(bf16_t*)(F.ws + WS_PROJ), PROJ_W, (const float*)(F.ws + WS_TAB), (const float*)(F.ws + WS_TAB) + 2048};
            pg8::gemm_phase<pg8::EpiProj, pg8::StaticOrder, true, true>(F.lds, g, S, E);
            SEAM(p0 + 0);
        }
        if (IN(p0 + 1)) {
            FRESH();
            phase_naive_up(F, l, l == DEPTH - 1);
            __syncthreads();
            phase_naive_ab(F, l, l == DEPTH - 1);
            phase_naive_d(F, l, l == DEPTH - 1);
            SEAM(p0 + 1);
        }
        if (IN(p0 + 2)) { FRESH(); phase_naive_c(F, l, l == DEPTH - 1); SEAM(p0 + 2); }
        if (IN(p0 + 3)) {
            FRESH();
            const int mrows = (l == DEPTH - 1) ? MMAIN : MALL;
            pg8::Gemm g{(const bf16_t*)(F.ws + WS_YCAT), wl(F, l, WO_OUT), mrows, DM, DM, DM}; pg8::StaticOrder S; S.init(mrows, DM, F.G, F.bid);
            pg8::EpiResid E{F.out, (float*)(F.ws + WS_XC), (const float*)(F.ws + WS_MOD) + (size_t)l * 9 * MODW + 2 * DM};
            pg8::gemm_phase<pg8::EpiResid, pg8::StaticOrder, true, true>(F.lds, g, S, E);
            SEAM(p0 + 3);
        }
        if (IN(p0 + 4)) { FRESH(); phase_ln(F, (l == DEPTH - 1) ? MMAIN : MALL, F.in[I_LN1G] + l * DM, F.in[I_LN1B] + l * DM, (const float*)(F.ws + WS_MOD) + (size_t)l * 9 * MODW, 3, 4); SEAM(p0 + 4); }
        if (IN(p0 + 5)) {
            FRESH();
            const int mrows = (l == DEPTH - 1) ? MMAIN : MALL;
            pg8::Gemm g{(const bf16_t*)(F.ws + WS_H), wl(F, l, WO_GU), mrows, 2 * FF, DM, DM}; pg8::StaticOrder S; S.init(mrows, 2 * FF, F.G, F.bid);
            pg8::EpiGu E{(bf16_t*)(F.ws + WS_ACT)};
            pg8::gemm_phase<pg8::EpiGu, pg8::StaticOrder, true, true>(F.lds, g, S, E);
            SEAM(p0 + 5);
        }
        if (IN(p0 + 6)) {
            FRESH();
            const int mrows = (l == DEPTH - 1) ? MMAIN : MALL;
            pg8::Gemm g{(const bf16_t*)(F.ws + WS_ACT), wl(F, l, WO_DN), mrows, DM, FF, FF}; pg8::StaticOrder S; S.init(mrows, DM, F.G, F.bid);
            pg8::EpiResid E{F.out, (float*)(F.ws + WS_XC), (const float*)(F.ws + WS_MOD) + (size_t)l * 9 * MODW + 5 * DM};
            pg8::gemm_phase<pg8::EpiResid, pg8::StaticOrder, true, true>(F.lds, g, S, E);
            SEAM(p0 + 6);
        }
        if (IN(p0 + 7)) { FRESH(); const bool last = (l == DEPTH - 1);
            phase_ln(F, last ? MMAIN : MALL, F.in[I_LN2G] + l * DM, F.in[I_LN2B] + l * DM, last ? nullptr : (const float*)(F.ws + WS_MOD) + (size_t)(l + 1) * 9 * MODW, 0, 1); SEAM(p0 + 7); }
}
__global__ void __launch_bounds__(NTHR, 2) mk_fwd(Args args) {
    extern __shared__ __attribute__((aligned(16))) unsigned char lds_raw[];
    Frame F; F.lds = (LAS unsigned char*)lds_raw; F.tid = threadIdx.x; F.lane = F.tid & 63; F.wave = __builtin_amdgcn_readfirstlane(F.tid >> 6);
    F.G = gridDim.x; F.bid = blockIdx.x; F.in = args.in; F.out = args.out; F.ws = args.ws;
    for (int u = F.tid; u < (LDS_BYTES - LDSCTL_OFF) / 4; u += NTHR) ((LAS unsigned*)(F.lds + LDSCTL_OFF))[u] = 0u;
    __syncthreads();
    XcdBarrier bar; bar.bar = (unsigned*)(F.ws + WS_CTL) + CW_BAR; bar.x = 0; bar.st = nullptr;
    const int use_bar = args.use_bar;
    if (use_bar) bar = xcd_barrier_post((unsigned*)(F.ws + WS_CTL) + CW_BAR, (volatile LAS unsigned*)(F.lds + LDSCTL_OFF + 64));
    const int lo = args.ph_lo, hi = args.ph_hi;
    if (IN(0)) { phase_prologue0(F); SEAM(0); }
    if (IN(1)) { phase_prologue1(F); SEAM(1); }
    layer_phases<0>(F, bar, lo, hi, use_bar);
    layer_phases<1>(F, bar, lo, hi, use_bar);
    layer_phases<2>(F, bar, lo, hi, use_bar);
    layer_phases<3>(F, bar, lo, hi, use_bar);
}
#undef IN
#undef SEAM
#undef FRESH

extern "C" void kernel_launch(void* const* d_in, const int* in_sizes, int n_in, void* d_out, int out_size, void* d_ws, size_t ws_size, hipStream_t stream) {
    static int grid = 0;
    if (grid == 0) {
        if (n_in != 24 || out_size != MMAIN * DM || ws_size < WS_END) { fprintf(stderr, "kernel_launch: unexpected shapes (n_in %d out %d ws %zu need %zu)\n", n_in, out_size, ws_size, (size_t)WS_END); grid = -1; return; }
        int dev = 0, cus = 0, per_cu = 0;
        hipGetDevice(&dev); hipDeviceGetAttribute(&cus, hipDeviceAttributeMultiprocessorCount, dev);
        hipFuncSetAttribute((const void*)mk_fwd, hipFuncAttributeMaxDynamicSharedMemorySize, LDS_BYTES);
        hipOccupancyMaxActiveBlocksPerMultiprocessor(&per_cu, (const void*)mk_fwd, NTHR, LDS_BYTES);
        (void)hipGetLastError();
        if (per_cu < 1) fprintf(stderr, "kernel_launch: occupancy query says %d blocks per CU\n", per_cu);
        grid = cus > 0 ? cus : 256;
    }
    if (grid < 0) return;
    hipMemsetAsync((char*)d_ws + WS_CTL, 0, CTL_ZERO_BYTES, stream);
    Args a{};
    for (int i = 0; i < 24; ++i) a.in[i] = (const float*)d_in[i];
    a.out = (float*)d_out; a.ws = (unsigned char*)d_ws;
#if MK_ONE_LAUNCH
    a.ph_lo = 0; a.ph_hi = NPHASE; a.use_bar = 1;
    void* kargs[] = {&a};
    hipError_t e = hipLaunchCooperativeKernel((const void*)mk_fwd, dim3(grid), dim3(NTHR), kargs, LDS_BYTES, stream);
    if (e != hipSuccess) fprintf(stderr, "cooperative launch failed: %s (grid %d)\n", hipGetErrorString(e), grid);
#else
    a.use_bar = 0;
    for (int ph = 0; ph < NPHASE; ++ph) { a.ph_lo = ph; a.ph_hi = ph + 1; hipLaunchKernelGGL(mk_fwd, dim3(grid), dim3(NTHR), LDS_BYTES, stream, a); }
#endif
}
```

```cpp
#include <hip/hip_runtime.h>
#include <cstdio>
#include <cstdint>

#ifndef USE_FAST_ABD
#define USE_FAST_ABD 1
#endif
#ifndef USE_FAST_C
#define USE_FAST_C 1
#endif
#ifndef MK_ONE_LAUNCH
#define MK_ONE_LAUNCH 1
#endif

#define LAS __attribute__((address_space(3)))
#define GAS __attribute__((address_space(1)))
typedef unsigned short bf16_t;
typedef short bf16x8 __attribute__((ext_vector_type(8)));
typedef float f32x4 __attribute__((ext_vector_type(4)));
typedef float f32x2 __attribute__((ext_vector_type(2)));
typedef unsigned u32x4 __attribute__((ext_vector_type(4)));
typedef unsigned u32x2 __attribute__((ext_vector_type(2)));

constexpr int DM = 1024, NBATCH = 8, SEQ = 2048, DEPTH = 4, CTXL = 256;
constexpr int MMAIN = NBATCH * SEQ, MCTX = NBATCH * CTXL, MALL = MMAIN + MCTX;
constexpr int PROJ_W = 2304, IN_W = 2208, FF = 2816, QCU_W = 384, KVU_W = 512, MODW = 6 * DM;
constexpr float LN_EPS = 1e-6f;
constexpr float DN_ALPHA = 1.6817928305074290f;
constexpr int PC_AK = 0, PC_AV = 128, PC_BK = 256, PC_BV = 512, PC_AQ = 768, PC_BQ = 1024, PC_CQ = 1280, PC_DU = 1536, PC_DV = 1792, PC_CKV = 2048, PC_CKR = 2176;

constexpr size_t MiB = 1u << 20;
constexpr size_t WS_CTL = 0, CTL_ZERO_BYTES = 1 * MiB;
constexpr size_t WS_MOD = 1 * MiB;
constexpr size_t WS_TAB = 2 * MiB;
constexpr size_t WS_W = 3 * MiB, WL_STRIDE = 24 * MiB;
constexpr size_t WO_IN = 0, WO_OUT = 4718592, WO_GU = WO_OUT + 2097152, WO_DN = WO_GU + 11534336, WO_UQ = WO_DN + 5767168, WO_UKV = WO_UQ + 262144, WO_DWS = WO_UKV + 262144;
static_assert(WO_DWS + 131072 <= WL_STRIDE, "weights per layer");
constexpr size_t WS_XC = WS_W + 4 * WL_STRIDE;
constexpr size_t WS_H = WS_XC + 8 * MiB;
constexpr size_t WS_YCAT = WS_H + 36 * MiB;
constexpr size_t WS_PROJ = WS_YCAT + 36 * MiB;
constexpr size_t WS_QCU = WS_PROJ + 81 * MiB;
constexpr size_t WS_KVU = WS_QCU + 14 * MiB;
constexpr size_t WS_ACT = WS_PROJ;
constexpr size_t WS_END = WS_KVU + 18 * MiB;
static_assert((size_t)MALL * FF * 2 <= WS_END - WS_ACT, "ACT overlay");

__device__ __forceinline__ unsigned f2bf(float f) { unsigned u = __builtin_bit_cast(unsigned, f); return (u + 0x7fffu + ((u >> 16) & 1u)) >> 16; }
__device__ __forceinline__ unsigned pk2(float lo, float hi) { return f2bf(lo) | (f2bf(hi) << 16); }
__device__ __forceinline__ float bf2f(bf16_t b) { return __builtin_bit_cast(float, (unsigned)b << 16); }
__device__ __forceinline__ float gelu_tanh(float x) { const float u = 0.7978845608028654f * (x + 0.044715f * x * x * x); const float e = __expf(2.f * u); const float th = 1.f - 2.f / (e + 1.f); return 0.5f * x * (1.f + th); }
__device__ __forceinline__ int perm_c(int p) { return (((p >> 3) ^ (p >> 4)) & 1) ? (p ^ 24) : p; }
__device__ __forceinline__ float wave_sum(float v) {
#pragma unroll
    for (int o = 1; o < 64; o <<= 1) v += __shfl_xor(v, o);
    return v;
}
__device__ __forceinline__ float wave_max(float v) {
#pragma unroll
    for (int o = 1; o < 64; o <<= 1) v = fmaxf(v, __shfl_xor(v, o));
    return v;
}

namespace pg8 {
constexpr int BM = 256, BK = 64, HALF = 128, HTB = HALF * BK * 2, STAGE_BYTES = 8 * HTB, NXCD = 8, WGM = 8;
__host__ __device__ __forceinline__ int lds_byte(int r, int c) { const int st = (r >> 4) * 2 + (c >> 5), rr = r & 15, cc = c & 31, ob = rr * 64 + cc * 2; return st * 1024 + (ob ^ (((ob >> 9) & 1) << 5)); }
__host__ __device__ __forceinline__ void stage_rc(int b, int& R, int& C) { const int st = b / 1024, sb = b % 1024, swz = sb ^ (((sb >> 9) & 1) << 5); R = (st >> 1) * 16 + swz / 64; C = (st & 1) * 32 + (swz % 64) / 2; }
__host__ __device__ __forceinline__ int perm32(int rho) { const int n = rho >> 4, i = rho & 15; return 8 * (i >> 2) + 4 * n + (i & 3); }

struct Unit { int pm, pn; };
struct Gemm { const bf16_t* A; const bf16_t* Bt; int M, N, K, lda; };

struct StaticOrder {
    int nM, nN, nwg, G, c;
    __host__ __device__ void init(int M, int N, int G_, int c_) { nM = M / BM; nN = N / BM; nwg = nM * nN; G = G_; c = c_; }
    __host__ __device__ bool next(int i, Unit& u) const {
        const long L = (long)i * G + c; if (L >= nwg) return false;
        int wgid = (int)L; { const int q = nwg / NXCD, r = nwg % NXCD, xcd = wgid % NXCD, off = wgid / NXCD; wgid = (xcd < r ? xcd * (q + 1) : r * (q + 1) + (xcd - r) * q) + off; }
        const int nig = WGM * nN, gid = wgid / nig, fm = gid * WGM, gsz = (nM - fm) < WGM ? (nM - fm) : WGM;
        u.pm = fm + ((wgid % nig) % gsz); u.pn = (wgid % nig) / gsz; return true;
    }
    __device__ __forceinline__ void a_ready(const Unit&) const {}
    __device__ __forceinline__ void done(const Unit&) const {}
};

__device__ __forceinline__ u32x2 pack4(f32x4 v) { u32x2 w; w.x = pk2(v[0], v[1]); w.y = pk2(v[2], v[3]); return w; }

struct EpiProj {
    static constexpr bool PERM = false, AFTER_DRAIN = false;
    bf16_t* O; int ldc; const float* tabA; const float* tabC;
    __device__ __forceinline__ void operator()(const f32x4 (&acc)[2][2][4][2], const Unit& u, int wr, int wc, int fr, int fq) const {
        const int row0 = u.pm * BM + wr * 64 + fr, col0 = u.pn * BM + wc * 32 + 4 * fq;
        const bool mainrows = u.pm < 64;
#pragma unroll
        for (int ai = 0; ai < 2; ++ai)
#pragma unroll
            for (int m = 0; m < 4; ++m) {
                const int row = row0 + ai * HALF + m * 16, t = row & 2047;
                bf16_t* rowp = O + (size_t)row * ldc + col0;
#pragma unroll
                for (int bj = 0; bj < 2; ++bj) {
                    f32x4 v0 = acc[ai][bj][m][0], v1 = acc[ai][bj][m][1];
                    int mode = 0;
                    if (mainrows) { if ((u.pn == 0 && bj == 0) || u.pn == 3) mode = 1; else if (u.pn == 8 && bj == 1 && wc == 0) mode = 2; }
                    if (mode == 1) {
                        const int pos = (wc & 1) ? (t & 63) : (t >> 6);
                        const f32x4 cs = *(const f32x4*)(tabA + pos * 32 + 4 * fq), sn = *(const f32x4*)(tabA + pos * 32 + 16 + 4 * fq);
                        const f32x4 o0 = v0 * cs - v1 * sn, o1 = v0 * sn + v1 * cs; v0 = o0; v1 = o1;
                    } else if (mode == 2) {
                        const int pos = (fq < 2) ? (t >> 6) : (t & 63);
                        const f32x4 cs = *(const f32x4*)(tabC + pos * 16 + 4 * (fq & 1)), sn = *(const f32x4*)(tabC + pos * 16 + 8 + 4 * (fq & 1));
                        const f32x4 o0 = v0 * cs - v1 * sn, o1 = v0 * sn + v1 * cs; v0 = o0; v1 = o1;
                    }
                    *(u32x2*)(rowp + bj * HALF) = pack4(v0); *(u32x2*)(rowp + bj * HALF + 16) = pack4(v1);
                }
            }
    }
};
struct EpiUp {
    static constexpr bool PERM = false, AFTER_DRAIN = false;
    bf16_t* O; int ldc; int ncols; const LAS float* rs; const float* tabC; int rope;
    __device__ __forceinline__ void operator()(const f32x4 (&acc)[2][2][4][2], const Unit& u, int wr, int wc, int fr, int fq) const {
        const int col0 = u.pn * BM + wc * 32 + 4 * fq;
        const bool dorope = rope && u.pm < 64;
#pragma unroll
        for (int ai = 0; ai < 2; ++ai)
#pragma unroll
            for (int m = 0; m < 4; ++m) {
                const int rloc = ai * HALF + wr * 64 + m * 16 + fr, row = u.pm * BM + rloc, t = row & 2047;
                const float s = rs[rloc];
                const int pos = (fq < 2) ? (t >> 6) : (t & 63);
                f32x4 cs = {1.f, 1.f, 1.f, 1.f}, sn = {0.f, 0.f, 0.f, 0.f};
                if (dorope) { cs = *(const f32x4*)(tabC + pos * 16 + 4 * (fq & 1)); sn = *(const f32x4*)(tabC + pos * 16 + 8 + 4 * (fq & 1)); }
                bf16_t* rowp = O + (size_t)row * ldc + col0;
#pragma unroll
                for (int bj = 0; bj < 2; ++bj) {
                    const int colb = u.pn * BM + bj * HALF + wc * 32;
                    if (colb < ncols) {
                        f32x4 v0 = acc[ai][bj][m][0] * s, v1 = acc[ai][bj][m][1] * s;
                        if (dorope && ((colb >> 5) % 3) == 2) { const f32x4 o0 = v0 * cs - v1 * sn, o1 = v0 * sn + v1 * cs; v0 = o0; v1 = o1; }
                        *(u32x2*)(rowp + bj * HALF) = pack4(v0); *(u32x2*)(rowp + bj * HALF + 16) = pack4(v1);
                    }
                }
                asm volatile("" ::: "memory");
            }
    }
};
struct EpiResid {
    static constexpr bool PERM = false, AFTER_DRAIN = false;
    float* Xmain; float* Xctx; const float* gate;
    __device__ __forceinline__ void operator()(const f32x4 (&acc)[2][2][4][2], const Unit& u, int wr, int wc, int fr, int fq) const {
        const int col0 = u.pn * BM + wc * 32 + 4 * fq;
        const int j = u.pm < 64 ? (u.pm >> 3) : 8;
        float* base = (u.pm < 64 ? Xmain + (size_t)u.pm * BM * DM : Xctx + (size_t)(u.pm - 64) * BM * DM) + col0;
        const float* g = gate + j * MODW + col0;
        f32x4 gv[2][2];
#pragma unroll
        for (int bj = 0; bj < 2; ++bj)
#pragma unroll
            for (int n = 0; n < 2; ++n) gv[bj][n] = *(const f32x4*)(g + bj * HALF + n * 16);
#pragma unroll
        for (int ai = 0; ai < 2; ++ai)
#pragma unroll
            for (int m = 0; m < 4; ++m) { float* rowp = base + (size_t)(ai * HALF + wr * 64 + m * 16 + fr) * DM;
#pragma unroll
                for (int bj = 0; bj < 2; ++bj)
#pragma unroll
                    for (int n = 0; n < 2; ++n) { f32x4 x = *(const f32x4*)(rowp + bj * HALF + n * 16); x = x * DN_ALPHA + gv[bj][n] * acc[ai][bj][m][n]; *(f32x4*)(rowp + bj * HALF + n * 16) = x; } }
    }
};
struct EpiGu {
    static constexpr bool PERM = false, AFTER_DRAIN = false;
    bf16_t* O;
    __device__ __forceinline__ void operator()(const f32x4 (&acc)[2][2][4][2], const Unit& u, int wr, int wc, int fr, int fq) const {
        const int row0 = u.pm * BM + wr * 64 + fr, col0 = u.pn * HALF + wc * 32 + 4 * fq;
#pragma unroll
        for (int ai = 0; ai < 2; ++ai)
#pragma unroll
            for (int m = 0; m < 4; ++m) { bf16_t* rowp = O + (size_t)(row0 + ai * HALF + m * 16) * FF + col0;
#pragma unroll
                for (int n = 0; n < 2; ++n) { const f32x4 g = acc[ai][0][m][n], uu = acc[ai][1][m][n]; f32x4 o;
#pragma unroll
                    for (int e = 0; e < 4; ++e) o[e] = g[e] * __builtin_amdgcn_rcpf(1.f + __builtin_amdgcn_exp2f(-1.4426950408889634f * g[e])) * uu[e];
                    *(u32x2*)(rowp + n * 16) = pack4(o); } }
    }
};

template <class Epi, class Sched, bool ALIGN_EPI = false, bool SP2 = false>
__device__ __forceinline__ void gemm_phase(LAS unsigned char* lds, const Gemm g, const Sched& S, const Epi& E) {
    const int tid = threadIdx.x, wid = __builtin_amdgcn_readfirstlane(tid >> 6), lane = tid & 63, wr = wid >> 2, wc = wid & 3, fr = lane & 15, fq = lane >> 4;
    const int K = g.K, nt = K / BK, lda = g.lda;
    unsigned voffA[2], voffB[2];
#pragma unroll
    for (int i = 0; i < 2; ++i) { int R, C; stage_rc(tid * 16 + i * 8192, R, C); const int Rb = Epi::PERM ? ((R & ~31) + perm32(R & 31)) : R;
        voffA[i] = (unsigned)(R * lda + C) * 2u; voffB[i] = (unsigned)(Rb * K + C) * 2u; }
    const size_t kstep = (size_t)(BK * 2);
    const size_t hsA = (size_t)HALF * lda * 2, hsB = (size_t)HALF * K * 2;
    const size_t tsA = 2 * hsA, tsB = 2 * hsB;
    const unsigned ldsw = (unsigned)wid * 1024u;
    const int aoff = lds_byte(wr * 64 + fr, fq * 8), boff = lds_byte(wc * 32 + fr, fq * 8);
#define PG8_SA(b, h) (((b) * 2 + (h)) * HTB)
#define PG8_SB(b, h) ((4 + (b) * 2 + (h)) * HTB)
#define PG8_STAGE(bufoff, gbase, voff) do { _Pragma("unroll") for (int _i = 0; _i < 2; ++_i) \
        __builtin_amdgcn_global_load_lds((const unsigned*)((const char*)(gbase) + (voff)[_i]), (LAS unsigned*)(lds + (bufoff) + ldsw + _i * 8192), 16, 0, 0); } while (0)
#define PG8_LDA(dst, b, h) do { _Pragma("unroll") for (int m = 0; m < 4; ++m) _Pragma("unroll") for (int k = 0; k < 2; ++k) dst[m][k] = *(const LAS bf16x8*)(lds + PG8_SA(b, h) + aoff + m * 2048 + k * 1024); } while (0)
#define PG8_LDB(dst, b, h) do { _Pragma("unroll") for (int n = 0; n < 2; ++n) _Pragma("unroll") for (int k = 0; k < 2; ++k) dst[n][k] = *(const LAS bf16x8*)(lds + PG8_SB(b, h) + boff + n * 2048 + k * 1024); } while (0)
#define PG8_MMA(ai, bj, At, Bt) do { __builtin_amdgcn_s_setprio(1); _Pragma("unroll") for (int m = 0; m < 4; ++m) _Pragma("unroll") for (int n = 0; n < 2; ++n) _Pragma("unroll") for (int k = 0; k < 2; ++k) \
        acc[ai][bj][m][n] = __builtin_amdgcn_mfma_f32_16x16x32_bf16(Bt[n][k], At[m][k], acc[ai][bj][m][n], 0, 0, 0); __builtin_amdgcn_s_setprio(0); } while (0)
#define PG8_WAIT_V(n) asm volatile("s_waitcnt vmcnt(" #n ")" ::: "memory")
#define PG8_WAIT_L(n) asm volatile("s_waitcnt lgkmcnt(" #n ")" ::: "memory")
#define PG8_BAR __builtin_amdgcn_s_barrier()
#define PG8_SCHED __builtin_amdgcn_sched_barrier(0)
    Unit cur, nxt; int ui = 0;
    if (!S.next(0, cur)) return;
    f32x4 acc[2][2][4][2];
#pragma unroll
    for (int a = 0; a < 2; ++a)
#pragma unroll
        for (int b = 0; b < 2; ++b)
#pragma unroll
            for (int m = 0; m < 4; ++m)
#pragma unroll
                for (int n = 0; n < 2; ++n) acc[a][b][m][n] = (f32x4){0.f, 0.f, 0.f, 0.f};
    bf16x8 At[4][2], B0[2][2], B1[2][2];
    const char* cA = (const char*)g.A + (size_t)cur.pm * tsA; const char* cB = (const char*)g.Bt + (size_t)cur.pn * tsB;
    S.a_ready(cur);
    if constexpr (SP2) {
        PG8_STAGE(PG8_SB(0, 0), cB, voffB); PG8_STAGE(PG8_SB(0, 1), cB + hsB, voffB); PG8_STAGE(PG8_SA(0, 0), cA, voffA); PG8_STAGE(PG8_SA(0, 1), cA + hsA, voffA);
        if (wr == 1) PG8_BAR;
        PG8_WAIT_V(2); PG8_BAR;
        PG8_STAGE(PG8_SB(1, 0), cB + kstep, voffB); PG8_STAGE(PG8_SA(1, 0), cA + kstep, voffA); PG8_STAGE(PG8_SB(1, 1), cB + hsB + kstep, voffB);
        PG8_WAIT_V(6); PG8_BAR;
    } else {
        PG8_STAGE(PG8_SB(0, 0), cB, voffB); PG8_STAGE(PG8_SA(0, 0), cA, voffA); PG8_STAGE(PG8_SB(0, 1), cB + hsB, voffB); PG8_STAGE(PG8_SA(0, 1), cA + hsA, voffA);
        if (wr == 1) PG8_BAR;
        PG8_WAIT_V(4); PG8_BAR;
        PG8_STAGE(PG8_SB(1, 0), cB + kstep, voffB); PG8_STAGE(PG8_SA(1, 0), cA + kstep, voffA); PG8_STAGE(PG8_SB(1, 1), cB + hsB + kstep, voffB);
        PG8_WAIT_V(6); PG8_BAR;
    }
    for (;;) {
        const bool has_next = S.next(ui + 1, nxt);
        const char* nA = has_next ? (const char*)g.A + (size_t)nxt.pm * tsA : cA; const char* nB = has_next ? (const char*)g.Bt + (size_t)nxt.pn * tsB : cB;
        for (int t = 0; t < nt; t += 2) {
            const bool last = (t == nt - 2);
            const char* a1 = cA + (size_t)(t + 1) * kstep;
            const char* a2 = last ? nA : cA + (size_t)(t + 2) * kstep; const char* b2 = last ? nB : cB + (size_t)(t + 2) * kstep;
            const char* a3 = a2 + kstep; const char* b3 = b2 + kstep;
            if (last && has_next) S.a_ready(nxt);
            if constexpr (SP2) {
            PG8_LDB(B0, 0, 0); PG8_LDB(B1, 0, 1); PG8_SCHED; PG8_LDA(At, 0, 0); PG8_STAGE(PG8_SA(1, 1), a1 + hsA, voffA);
            PG8_WAIT_V(8); PG8_WAIT_L(0); PG8_BAR; PG8_MMA(0, 0, At, B0); PG8_MMA(0, 1, At, B1); PG8_BAR; PG8_SCHED;
            PG8_LDA(At, 0, 1); PG8_STAGE(PG8_SB(0, 0), b2, voffB); PG8_STAGE(PG8_SB(0, 1), b2 + hsB, voffB); PG8_STAGE(PG8_SA(0, 0), a2, voffA);
            PG8_WAIT_V(8); PG8_WAIT_L(0); PG8_BAR; PG8_MMA(1, 0, At, B0); PG8_MMA(1, 1, At, B1); PG8_BAR; PG8_SCHED;
            PG8_LDB(B0, 1, 0); PG8_LDB(B1, 1, 1); PG8_SCHED; PG8_LDA(At, 1, 0); PG8_STAGE(PG8_SA(0, 1), a2 + hsA, voffA);
            PG8_WAIT_V(8); PG8_WAIT_L(0); PG8_BAR; PG8_MMA(0, 0, At, B0); PG8_MMA(0, 1, At, B1); PG8_BAR; PG8_SCHED;
            PG8_LDA(At, 1, 1); PG8_STAGE(PG8_SB(1, 0), b3, voffB); PG8_STAGE(PG8_SB(1, 1), b3 + hsB, voffB); PG8_STAGE(PG8_SA(1, 0), a3, voffA);
            PG8_WAIT_V(8); PG8_WAIT_L(0); PG8_BAR; PG8_MMA(1, 0, At, B0); PG8_MMA(1, 1, At, B1); PG8_BAR; PG8_SCHED;
            } else {
            PG8_LDB(B0, 0, 0); PG8_SCHED; PG8_LDA(At, 0, 0); PG8_STAGE(PG8_SA(1, 1), a1 + hsA, voffA);
            PG8_WAIT_L(8); PG8_BAR; PG8_WAIT_L(0); PG8_MMA(0, 0, At, B0); PG8_BAR; PG8_SCHED;
            PG8_LDB(B1, 0, 1); PG8_STAGE(PG8_SB(0, 0), b2, voffB);
            PG8_BAR; PG8_WAIT_L(0); PG8_MMA(0, 1, At, B1); PG8_BAR;
            PG8_LDA(At, 0, 1); PG8_STAGE(PG8_SA(0, 0), a2, voffA);
            PG8_BAR; PG8_WAIT_L(0); PG8_MMA(1, 0, At, B0); PG8_BAR; PG8_SCHED;
            PG8_STAGE(PG8_SB(0, 1), b2 + hsB, voffB);
            PG8_WAIT_V(6); PG8_BAR; PG8_MMA(1, 1, At, B1); PG8_BAR;
            PG8_LDB(B0, 1, 0); PG8_SCHED; PG8_LDA(At, 1, 0); PG8_STAGE(PG8_SA(0, 1), a2 + hsA, voffA);
            PG8_WAIT_L(8); PG8_BAR; PG8_WAIT_L(0); PG8_MMA(0, 0, At, B0); PG8_BAR; PG8_SCHED;
            PG8_LDB(B1, 1, 1); PG8_STAGE(PG8_SB(1, 0), b3, voffB);
            PG8_BAR; PG8_WAIT_L(0); PG8_MMA(0, 1, At, B1); PG8_BAR;
            PG8_LDA(At, 1, 1); PG8_STAGE(PG8_SA(1, 0), a3, voffA);
            PG8_BAR; PG8_WAIT_L(0); PG8_MMA(1, 0, At, B0); PG8_BAR; PG8_SCHED;
            PG8_STAGE(PG8_SB(1, 1), b3 + hsB, voffB);
            PG8_WAIT_V(6); PG8_BAR; PG8_MMA(1, 1, At, B1); PG8_BAR;
            }
        }
        if constexpr (ALIGN_EPI) { if (wr == 0) PG8_BAR; }
        if constexpr (!Epi::AFTER_DRAIN) { E(acc, cur, wr, wc, fr, fq); S.done(cur); }
        if (!has_next) break;
#pragma unroll
        for (int a = 0; a < 2; ++a)
#pragma unroll
            for (int b = 0; b < 2; ++b)
#pragma unroll
                for (int m = 0; m < 4; ++m)
#pragma unroll
                    for (int n = 0; n < 2; ++n) acc[a][b][m][n] = (f32x4){0.f, 0.f, 0.f, 0.f};
        cur = nxt; cA = nA; cB = nB; ++ui;
        if constexpr (ALIGN_EPI) { if (wr == 1) PG8_BAR; }
    }
    PG8_WAIT_V(0);
    if constexpr (!ALIGN_EPI) { if (wr == 0) PG8_BAR; }
    PG8_BAR;
#undef PG8_SA
#undef PG8_SB
#undef PG8_STAGE
#undef PG8_LDA
#undef PG8_LDB
#undef PG8_MMA
#undef PG8_WAIT_V
#undef PG8_WAIT_L
#undef PG8_BAR
#undef PG8_SCHED
}
}

typedef GAS unsigned gu32;
#define RLX_AGENT __ATOMIC_RELAXED, __HIP_MEMORY_SCOPE_AGENT
#define XB_TMO      128
#define XB_XCNT(j)  (256  + 64 * (j))
#define XB_XSUB(j)  (1280 + 64 * (j))
#define XB_XGEN(j)  (2304 + 64 * (j))
#define XB_TOP      3328
#define XB_TOPGEN   3392
#define XCD_BAR_WORDS 3456
#define XB_SPIN_CAP (1u << 18)
__device__ __forceinline__ unsigned xb_ld(unsigned* p)              { return __hip_atomic_load(p, __ATOMIC_RELAXED, __HIP_MEMORY_SCOPE_AGENT); }
__device__ __forceinline__ unsigned xb_add(unsigned* p, unsigned v) { return __hip_atomic_fetch_add(p, v, __ATOMIC_RELAXED, __HIP_MEMORY_SCOPE_AGENT); }
__device__ __forceinline__ unsigned xb_xcc_id() { return (unsigned)__builtin_amdgcn_s_getreg((3 << 11) | 20) & 0xFu; }
#define XB_SPIN(cond, bar) do { unsigned _sp = 0; while (cond) { __builtin_amdgcn_s_sleep(1); \
    if ((++_sp & 255u) == 0u) { if (xb_ld(&(bar)[XB_TMO])) break; if (_sp > XB_SPIN_CAP) { atomicAdd(&(bar)[XB_TMO], 1u); break; } } } } while (0)
struct XcdBarrier { unsigned* bar; unsigned x; volatile LAS unsigned* st; };
__device__ __forceinline__ XcdBarrier xcd_barrier_post(unsigned* bar, volatile LAS unsigned* st) {
    XcdBarrier b; b.bar = bar; b.x = xb_xcc_id(); b.st = st;
    if (threadIdx.x == 0) (void)xb_add(&bar[XB_XCNT(b.x)], 1u);
    return b;
}
__device__ __forceinline__ void xcd_barrier_complete(unsigned* bar, unsigned x, unsigned& nloc, unsigned& nx) {
    const unsigned G = gridDim.x * gridDim.y * gridDim.z;
    unsigned sum, cnt, mine, sp = 0u;
    for (;;) {
        sum = 0u; cnt = 0u; mine = 0u;
#pragma unroll
        for (unsigned j = 0; j < 16; ++j) { const unsigned c = xb_ld(&bar[XB_XCNT(j)]); sum += c; cnt += (c > 0u) ? 1u : 0u; mine = (j == x) ? c : mine; }
        if (sum == G) break;
        __builtin_amdgcn_s_sleep(1);
        if ((++sp & 255u) == 0u) { if (xb_ld(&bar[XB_TMO])) break; if (sp > XB_SPIN_CAP) { atomicAdd(&bar[XB_TMO], 1u); break; } }
    }
    nloc = mine > 0u ? mine : 1u; nx = cnt > 0u ? cnt : 1u;
}
__device__ __forceinline__ void xcd_barrier(const XcdBarrier& b) {
    asm volatile("s_waitcnt vmcnt(0)" ::: "memory");
    __syncthreads();
    if (threadIdx.x == 0) {
        unsigned* bar = b.bar;
        __builtin_amdgcn_s_waitcnt(0);
        unsigned nloc = b.st[0], nx = b.st[1];
        if (nloc == 0u) { xcd_barrier_complete(bar, b.x, nloc, nx); b.st[0] = nloc; b.st[1] = nx; }
        const unsigned old = xb_add(&bar[XB_XSUB(b.x)], 1u);
        const unsigned gen = old / nloc;
        if (old + 1u == (gen + 1u) * nloc) {
            __builtin_amdgcn_fence(__ATOMIC_RELEASE, "agent");
            asm volatile("s_waitcnt vmcnt(0)" ::: "memory");
            const unsigned og = xb_add(&bar[XB_TOP], 1u);
            const unsigned tg = og / nx;
            if (og + 1u == (tg + 1u) * nx) xb_add(&bar[XB_TOPGEN], 1u);
            else XB_SPIN(xb_ld(&bar[XB_TOPGEN]) == tg, bar);
            __builtin_amdgcn_fence(__ATOMIC_ACQUIRE, "agent");
            xb_add(&bar[XB_XGEN(b.x)], 1u);
            asm volatile("s_waitcnt vmcnt(0)" ::: "memory");
        } else {
            XB_SPIN(xb_ld(&bar[XB_XGEN(b.x)]) == gen, bar);
            __builtin_amdgcn_fence(__ATOMIC_ACQUIRE, "agent");
            asm volatile("s_waitcnt vmcnt(0)" ::: "memory");
        }
    }
    __syncthreads();
}

constexpr int NWAVES = 8, NTHR = 512;
constexpr int RING_BYTES = 131072, TABL_OFF = RING_BYTES  , LDSCTL_OFF = RING_BYTES + 1024, LDS_BYTES = 147456;
constexpr int CW_BAR = 4096;

struct Args { const float* in[24]; float* out; unsigned char* ws; int ph_lo, ph_hi, use_bar, pad; };
enum { I_X = 0, I_C, I_CTX, I_CCTX, I_WMOD, I_BMOD, I_WIN, I_ASINK, I_BRPB, I_CQN, I_CKVN, I_WUQ, I_WUKV, I_DLNG, I_DLNB, I_DWS, I_DBS, I_WOUT, I_LN1G, I_LN1B, I_WGU, I_WDN, I_LN2G, I_LN2B };

struct Frame {
    LAS unsigned char* lds; int tid, lane, wave, G, bid;
    const float* const* in; float* out; unsigned char* ws;
};
__device__ __forceinline__ bf16_t* wl(const Frame& F, int l, size_t off) { return (bf16_t*)(F.ws + WS_W + (size_t)l * WL_STRIDE + off); }

template <int MAP> __device__ __forceinline__ int rowmap(int n) {
    if (MAP == 1) {
        if (n < 768) return n;
        if (n < 896) return PC_CKV + (n - 768);
        if (n < 928) return PC_CKR + perm_c(n - 896);
        if (n < 1184) return PC_AQ + (n - 928);
        if (n < 1440) return PC_BQ + (n - 1184);
        if (n < 1696) return PC_CQ + (n - 1440);
        if (n < 1952) return PC_DU + (n - 1696);
        return PC_DV + (n - 1952);
    }
    if (MAP == 2) { if (n < FF) return (n >> 7) * 256 + (n & 127); const int i = n - FF; return (i >> 7) * 256 + 128 + (i & 127); }
    if (MAP == 3) { const int h = n / 96, e = n % 96; return e < 64 ? n : h * 96 + 64 + perm_c(e - 64); }
    return n;
}
template <int MAP> __device__ __forceinline__ void transpose_item(const float* W, int K, int N, bf16_t* WT, int ldk, const float* kscale, LAS float* scr, int item, int lane) {
    const int nblk = N / 32, kb = item / nblk, nb = item % nblk, k0 = 64 * kb, n0 = 32 * nb;
#pragma unroll 8
    for (int i = 0; i < 32; ++i) { const int kk = 2 * i + (lane >> 5); float v = W[(size_t)(k0 + kk) * N + n0 + (lane & 31)]; if (kscale) v *= kscale[k0 + kk]; scr[kk * 33 + (lane & 31)] = v; }
    asm volatile("s_waitcnt lgkmcnt(0)" ::: "memory");
    const int c = lane & 7;
#pragma unroll
    for (int j = 0; j < 4; ++j) { const int n = (lane >> 3) + 8 * j; const LAS float* s = scr + (8 * c) * 33 + n;
        u32x4 o; o.x = pk2(s[0 * 33], s[1 * 33]); o.y = pk2(s[2 * 33], s[3 * 33]); o.z = pk2(s[4 * 33], s[5 * 33]); o.w = pk2(s[6 * 33], s[7 * 33]);
        *(u32x4*)(WT + (size_t)rowmap<MAP>(n0 + n) * ldk + k0 + 8 * c) = o; }
    asm volatile("s_waitcnt lgkmcnt(0)" ::: "memory");
}
__device__ __forceinline__ void phase_prologue0(Frame& F) {
    LAS float* sv = (LAS float*)(F.lds);
    LAS float* red = (LAS float*)(F.lds + 36864);
    for (int i = F.tid; i < 9 * 1024; i += NTHR) { const int j = i >> 10, k = i & 1023; const float v = j < 8 ? F.in[I_C][j * 1024 + k] : F.in[I_CCTX][k]; sv[i] = v / (1.f + __expf(-v)); }
    __syncthreads();
    for (int u = F.bid; u < DEPTH * (MODW / 64); u += F.G) {
        const int l = u / (MODW / 64), c0 = (u % (MODW / 64)) * 64;
        const float* W = F.in[I_WMOD] + (size_t)l * DM * MODW + c0 + F.lane;
        float a[9];
#pragma unroll
        for (int j = 0; j < 9; ++j) a[j] = 0.f;
        const int kb = F.wave * 128;
#pragma unroll 4
        for (int k = 0; k < 128; ++k) { const float w = W[(size_t)(kb + k) * MODW];
#pragma unroll
            for (int j = 0; j < 9; ++j) a[j] += sv[j * 1024 + kb + k] * w; }
#pragma unroll
        for (int j = 0; j < 9; ++j) red[(F.wave * 9 + j) * 64 + F.lane] = a[j];
        __syncthreads();
        for (int i = F.tid; i < 9 * 64; i += NTHR) { const int j = i >> 6, c = i & 63; float s = 0.f;
#pragma unroll
            for (int w = 0; w < 8; ++w) s += red[(w * 9 + j) * 64 + c];
            ((float*)(F.ws + WS_MOD))[((size_t)l * 9 + j) * MODW + c0 + c] = s + F.in[I_BMOD][l * MODW + c0 + c]; }
        __syncthreads();
    }
    __syncthreads();
    LAS float* scr = (LAS float*)(F.lds + F.wave * 16384);
    const int gw = F.bid * NWAVES + F.wave, NGW = F.G * NWAVES;
    constexpr int I_IN = 16 * (IN_W / 32), I_OUT = 16 * 32, I_GU = 16 * (2 * FF / 32), I_DN = (FF / 64) * 32, I_UQ = 4 * (QCU_W / 32), I_UKV = 2 * (KVU_W / 32);
    constexpr int PER_L = I_IN + I_OUT + I_GU + I_DN;
    for (int it = gw; it < DEPTH * PER_L; it += NGW) {
        const int l = it / PER_L; int r = it % PER_L;
        if (r < I_IN) { transpose_item<1>(F.in[I_WIN] + (size_t)l * DM * IN_W, DM, IN_W, wl(F, l, WO_IN), DM, nullptr, scr, r, F.lane); continue; } r -= I_IN;
        if (r < I_OUT) { transpose_item<0>(F.in[I_WOUT] + (size_t)l * DM * DM, DM, DM, wl(F, l, WO_OUT), DM, nullptr, scr, r, F.lane); continue; } r -= I_OUT;
        if (r < I_GU) { transpose_item<2>(F.in[I_WGU] + (size_t)l * DM * 2 * FF, DM, 2 * FF, wl(F, l, WO_GU), DM, nullptr, scr, r, F.lane); continue; } r -= I_GU;
        transpose_item<0>(F.in[I_WDN] + (size_t)l * FF * DM, FF, DM, wl(F, l, WO_DN), FF, nullptr, scr, r, F.lane);
    }
    {
        constexpr int Z_IN = 96 * DM / 8;
        const int gt = F.bid * NTHR + F.tid, NGT = F.G * NTHR; const u32x4 z = {0u, 0u, 0u, 0u};
        for (int i = gt; i < DEPTH * Z_IN; i += NGT) { const int l = i / Z_IN, r = i % Z_IN; *(u32x4*)(wl(F, l, WO_IN) + (size_t)IN_W * DM + (size_t)r * 8) = z; }
        for (int i = gt; i < DEPTH * 256 * QCU_W; i += NGT) { const int l = i / (256 * QCU_W), e = i % (256 * QCU_W), k = e / QCU_W, n = e % QCU_W;
            wl(F, l, WO_UQ)[k * QCU_W + rowmap<3>(n)] = (bf16_t)f2bf(F.in[I_WUQ][i] * F.in[I_CQN][l * 256 + k]); }
        for (int i = gt; i < DEPTH * 128 * KVU_W; i += NGT) { const int l = i / (128 * KVU_W), e = i % (128 * KVU_W), k = e / KVU_W;
            wl(F, l, WO_UKV)[e] = (bf16_t)f2bf(F.in[I_WUKV][i] * F.in[I_CKVN][l * 128 + k]); }
        for (int i = gt; i < DEPTH * 65536; i += NGT) { const int l = i >> 16, e = i & 65535; wl(F, l, WO_DWS)[e] = (bf16_t)f2bf(F.in[I_DWS][i]); }
        float* tabA = (float*)(F.ws + WS_TAB); float* tabC = tabA + 2048;
        for (int i = gt; i < 64 * 16; i += NGT) { const int pos = i >> 4, k = i & 15; const float inv = powf(10000.f, -(float)k / 16.f), ang = (float)pos * inv; tabA[pos * 32 + k] = cosf(ang); tabA[pos * 32 + 16 + k] = sinf(ang); }
        for (int i = gt; i < 64 * 8; i += NGT) { const int pos = i >> 3, k = i & 7; const float inv = powf(10000.f, -(float)k / 8.f), ang = (float)pos * inv; tabC[pos * 16 + k] = cosf(ang); tabC[pos * 16 + 8 + k] = sinf(ang); }
    }
}
__device__ __forceinline__ void store_h_row(bf16_t* hrow, const f32x4 (&v)[4], const float* sh, const float* sc, int lane) {
#pragma unroll
    for (int j = 0; j < 4; ++j) { const int c = 4 * lane + 256 * j; const f32x4 s = *(const f32x4*)(sc + c), b = *(const f32x4*)(sh + c); const f32x4 h = v[j] * (s + 1.f) + b;
        *(u32x2*)(hrow + c) = pg8::pack4(h); }
}
__device__ __forceinline__ void phase_prologue1(Frame& F) {
    const int gw = F.bid * NWAVES + F.wave, NGW = F.G * NWAVES;
    const float* mod = (const float*)(F.ws + WS_MOD);
    bf16_t* H = (bf16_t*)(F.ws + WS_H); float* XC = (float*)(F.ws + WS_XC);
    for (int r = gw; r < MALL; r += NGW) {
        const bool mainr = r < MMAIN; const int j = mainr ? (r >> 11) : 8;
        const float* src = mainr ? F.in[I_X] + (size_t)r * DM : F.in[I_CTX] + (size_t)(r - MMAIN) * DM;
        float* dst = mainr ? F.out + (size_t)r * DM : XC + (size_t)(r - MMAIN) * DM;
        f32x4 v[4];
#pragma unroll
        for (int jj = 0; jj < 4; ++jj) { v[jj] = *(const f32x4*)(src + 4 * F.lane + 256 * jj); *(f32x4*)(dst + 4 * F.lane + 256 * jj) = v[jj]; }
        store_h_row(H + (size_t)r * DM, v, mod + (size_t)j * MODW, mod + (size_t)j * MODW + DM, F.lane);
    }
}
__device__ __forceinline__ void phase_ln(Frame& F, int mrows, const float* g, const float* b, const float* modl  , int sh_chunk, int sc_chunk) {
    const int gw = F.bid * NWAVES + F.wave, NGW = F.G * NWAVES;
    bf16_t* H = (bf16_t*)(F.ws + WS_H); float* XC = (float*)(F.ws + WS_XC);
    for (int r = gw; r < mrows; r += NGW) {
        const bool mainr = r < MMAIN; const int j = mainr ? (r >> 11) : 8;
        float* xr = mainr ? F.out + (size_t)r * DM : XC + (size_t)(r - MMAIN) * DM;
        f32x4 v[4]; float s = 0.f;
#pragma unroll
        for (int jj = 0; jj < 4; ++jj) { v[jj] = *(const f32x4*)(xr + 4 * F.lane + 256 * jj); s += (v[jj][0] + v[jj][1]) + (v[jj][2] + v[jj][3]); }
        const float mean = wave_sum(s) * (1.f / DM); float s2 = 0.f;
#pragma unroll
        for (int jj = 0; jj < 4; ++jj) { v[jj] = v[jj] - mean; s2 += (v[jj][0] * v[jj][0] + v[jj][1] * v[jj][1]) + (v[jj][2] * v[jj][2] + v[jj][3] * v[jj][3]); }
        const float rstd = 1.f / sqrtf(wave_sum(s2) * (1.f / DM) + LN_EPS);
#pragma unroll
        for (int jj = 0; jj < 4; ++jj) { const int c = 4 * F.lane + 256 * jj; v[jj] = v[jj] * rstd * *(const f32x4*)(g + c) + *(const f32x4*)(b + c); *(f32x4*)(xr + c) = v[jj]; }
        if (modl) store_h_row(H + (size_t)r * DM, v, modl + (size_t)j * MODW + sh_chunk * DM, modl + (size_t)j * MODW + sc_chunk * DM, F.lane);
    }
}

typedef float f32x16 __attribute__((ext_vector_type(16)));
typedef short s16x4 __attribute__((ext_vector_type(4)));
typedef __bf16 bf16x2_t __attribute__((ext_vector_type(2)));
__device__ __forceinline__ int crow(int r, int hi) { return (r & 3) + 8 * (r >> 2) + 4 * hi; }
__device__ __forceinline__ float swapmax(float v) { auto rr = __builtin_amdgcn_permlane32_swap(__float_as_uint(v), __float_as_uint(v), false, false); return fmaxf(__uint_as_float(rr[0]), __uint_as_float(rr[1])); }
__device__ __forceinline__ float swapsum(float v) { auto rr = __builtin_amdgcn_permlane32_swap(__float_as_uint(v), __float_as_uint(v), false, false); return __uint_as_float(rr[0]) + __uint_as_float(rr[1]); }
__device__ __forceinline__ unsigned cvtpk(float lo, float hi) { f32x2 v = {lo, hi}; bf16x2_t b = __builtin_convertvector(v, bf16x2_t); return __builtin_bit_cast(unsigned, b); }
__device__ __forceinline__ s16x4 vtr(const LAS unsigned char* p) { return __builtin_bit_cast(s16x4, __builtin_amdgcn_ds_read_tr16_b64_v4i16((LAS s16x4*)p)); }
constexpr float LOG2E = 1.4426950408889634f;
constexpr int WSF_OFF = RING_BYTES + 1024 + 512;
constexpr int BTAB_OFF = RING_BYTES + 4096;

template <int DQK, int NHT, class Cfg>
__device__ __forceinline__ void flash_unit(const Cfg& cfg, LAS unsigned char* lds, int tid) {
    constexpr int KPL = DQK / 8, KBYTES = NHT * KPL * 1024, VBYTES = NHT * 8192, BUF = KBYTES + VBYTES, NK = DQK / 16;
    static_assert(2 * BUF <= RING_BYTES, "flash buffers");
    const int lane = tid & 63, r32 = lane & 31, hi = lane >> 5, w = __builtin_amdgcn_readfirstlane(tid >> 6);
    LAS float* wsf = (LAS float*)(lds + WSF_OFF) + w * 64;
    const int NT = cfg.ntiles, hs = cfg.hslice(w);
    auto issue = [&](int t, int b) {
        const int row0 = cfg.row0(t);
#pragma unroll
        for (int i = 0; i < (NHT * KPL + 7) / 8; ++i) { const int pl = w + 8 * i;
            if (pl < NHT * KPL) __builtin_amdgcn_global_load_lds((const unsigned*)cfg.ksrc(row0 + lane, pl), (LAS unsigned*)(lds + b * BUF + pl * 1024), 16, 0, 0); }
#pragma unroll
        for (int i = 0; i < NHT; ++i) { const int pv = w + 8 * i, head = pv >> 3, wv = pv & 7;
            __builtin_amdgcn_global_load_lds((const unsigned*)(cfg.vsrc(row0 + 16 * (wv & 3) + (lane >> 2), head) + (wv >> 2) * 32 + (lane & 3) * 8), (LAS unsigned*)(lds + b * BUF + KBYTES + pv * 1024), 16, 0, 0); }
    };
    issue(0, 0);
    bf16x8 qr[NK];
    { const bf16_t* qp = cfg.qrow(w, r32);
#pragma unroll
      for (int d0 = 0; d0 < NK; ++d0) qr[d0] = *(const bf16x8*)(qp + 16 * d0 + 8 * hi); }
    cfg.fixq(qr, w, r32, hi);
    float m = cfg.m_init(w), l = (hi == 0) ? cfg.l_init() : 0.f;
    typename Cfg::State st; cfg.init_state(st, w, r32, hi);
    f32x16 o0, o1;
#pragma unroll
    for (int r = 0; r < 16; ++r) { o0[r] = 0.f; o1[r] = 0.f; }
    asm volatile("s_waitcnt vmcnt(0)" ::: "memory"); __syncthreads();
    for (int t = 0; t < NT; ++t) {
        const int b = t & 1;
        if (t + 1 < NT) issue(t + 1, b ^ 1);
        if (cfg.active(t, w)) {
            const LAS unsigned char* Kb = lds + b * BUF + hs * (KPL * 1024) + hi * 1024 + r32 * 16;
            const LAS unsigned char* Vb = lds + b * BUF + KBYTES + hs * 8192 + ((lane >> 4) & 1) * 32 + (lane & 3) * 8 + (4 * hi + ((lane & 15) >> 2)) * 64;
            f32x16 p0, p1;
#pragma unroll
            for (int r = 0; r < 16; ++r) { p0[r] = 0.f; p1[r] = 0.f; }
#pragma unroll
            for (int d0 = 0; d0 < NK; ++d0) {
                const bf16x8 k0 = *(const LAS bf16x8*)(Kb + d0 * 2048), k1 = *(const LAS bf16x8*)(Kb + d0 * 2048 + 512);
                p0 = __builtin_amdgcn_mfma_f32_32x32x16_bf16(k0, qr[d0], p0, 0, 0, 0);
                p1 = __builtin_amdgcn_mfma_f32_32x32x16_bf16(k1, qr[d0], p1, 0, 0, 0);
            }
            cfg.transform(p0, p1, t, w, r32, hi, st);
            float mx = fmaxf(p0[0], p1[0]);
#pragma unroll
            for (int r = 1; r < 16; ++r) mx = fmaxf(mx, fmaxf(p0[r], p1[r]));
            mx = swapmax(mx);
            if (__any(mx > m + 8.f)) {
                const float mn = fmaxf(m, mx), alpha = __builtin_amdgcn_exp2f(m - mn);
                l *= alpha; m = mn;
                if (hi == 0) wsf[r32] = alpha;
                asm volatile("s_waitcnt lgkmcnt(0)" ::: "memory");
#pragma unroll
                for (int r = 0; r < 16; ++r) { const float a = wsf[crow(r, hi)]; o0[r] *= a; o1[r] *= a; }
            }
            float sum = 0.f;
#pragma unroll
            for (int r = 0; r < 16; ++r) { p0[r] = __builtin_amdgcn_exp2f(p0[r] - m); p1[r] = __builtin_amdgcn_exp2f(p1[r] - m); sum += p0[r] + p1[r]; }
            l += sum;
            u32x4 pw[4];
#pragma unroll
            for (int k = 0; k < 2; ++k) {
                pw[k] = (u32x4){cvtpk(p0[8 * k], p0[8 * k + 1]), cvtpk(p0[8 * k + 2], p0[8 * k + 3]), cvtpk(p0[8 * k + 4], p0[8 * k + 5]), cvtpk(p0[8 * k + 6], p0[8 * k + 7])};
                pw[2 + k] = (u32x4){cvtpk(p1[8 * k], p1[8 * k + 1]), cvtpk(p1[8 * k + 2], p1[8 * k + 3]), cvtpk(p1[8 * k + 4], p1[8 * k + 5]), cvtpk(p1[8 * k + 6], p1[8 * k + 7])};
            }
#pragma unroll
            for (int ks = 0; ks < 4; ++ks) {
                const s16x4 a0 = vtr(Vb + ks * 1024), a1 = vtr(Vb + ks * 1024 + 512), b0 = vtr(Vb + 4096 + ks * 1024), b1 = vtr(Vb + 4096 + ks * 1024 + 512);
                const bf16x8 v0 = {a0[0], a0[1], a0[2], a0[3], a1[0], a1[1], a1[2], a1[3]}, v1 = {b0[0], b0[1], b0[2], b0[3], b1[0], b1[1], b1[2], b1[3]};
                const bf16x8 pa = __builtin_bit_cast(bf16x8, pw[ks]);
                o0 = __builtin_amdgcn_mfma_f32_32x32x16_bf16(pa, v0, o0, 0, 0, 0);
                o1 = __builtin_amdgcn_mfma_f32_32x32x16_bf16(pa, v1, o1, 0, 0, 0);
            }
        }
        asm volatile("s_waitcnt vmcnt(0) lgkmcnt(0)" ::: "memory"); __syncthreads();
    }
    l = swapsum(l);
    if (hi == 0) wsf[32 + r32] = 1.f / l;
    asm volatile("s_waitcnt lgkmcnt(0)" ::: "memory");
#pragma unroll
    for (int r = 0; r < 16; ++r) { const int q = crow(r, hi); const float inv = wsf[32 + q]; bf16_t* op = cfg.orow(w, q);
        op[r32] = (bf16_t)f2bf(o0[r] * inv); op[32 + r32] = (bf16_t)f2bf(o1[r] * inv); }
    asm volatile("s_waitcnt lgkmcnt(0)" ::: "memory");
}

struct CfgA {
    const bf16_t* PROJ; bf16_t* YC; int ctxu, b, n, hkv, hq, ktlo, nloc, ntiles; float sink0, sink1;
    __device__ __forceinline__ int row0(int t) const { return ctxu ? MMAIN + b * CTXL + 64 * t : (t < nloc ? b * SEQ + 128 * n - 128 + 64 * (ktlo + t) : MMAIN + b * CTXL + 64 * (t - nloc)); }
    __device__ __forceinline__ const bf16_t* ksrc(int row, int pl) const { return PROJ + (size_t)row * PROJ_W + PC_AK + 64 * hkv + 8 * pl; }
    __device__ __forceinline__ const bf16_t* vsrc(int row, int) const { return PROJ + (size_t)row * PROJ_W + PC_AV + 64 * hkv; }
    __device__ __forceinline__ int qtok(int w, int q) const { return ctxu ? MMAIN + b * CTXL + 32 * w + q : b * SEQ + 128 * n + 32 * (w & 3) + q; }
    __device__ __forceinline__ int qhead(int w) const { return ctxu ? hq : 2 * hkv + (w >> 2); }
    __device__ __forceinline__ void fixq(bf16x8*, int, int, int) const {}
    __device__ __forceinline__ const bf16_t* qrow(int w, int r32) const { return PROJ + (size_t)qtok(w, r32) * PROJ_W + PC_AQ + 64 * qhead(w); }
    __device__ __forceinline__ bf16_t* orow(int w, int q) const { return YC + (size_t)qtok(w, q) * DM + 64 * qhead(w); }
    __device__ __forceinline__ int hslice(int) const { return 0; }
    __device__ __forceinline__ bool active(int t, int w) const { if (ctxu || t >= nloc) return true; const int kt = ktlo + t, pw = w & 3; return !((kt == 0 && pw >= 2) || (kt == 5 && pw <= 1)); }
    __device__ __forceinline__ float m_init(int w) const { return (ctxu ? sink0 : ((w >> 2) ? sink1 : sink0)) * LOG2E; }
    __device__ __forceinline__ float l_init() const { return 1.f; }
    struct State {}; __device__ __forceinline__ void init_state(State&, int, int, int) const {}
    __device__ __forceinline__ void transform(f32x16& p0, f32x16& p1, int t, int w, int r32, int hi, const State&) const {
        const float c = 0.125f * LOG2E;
        if (!ctxu && t < nloc) {
            const int d0 = (64 * (ktlo + t) - 128) - (32 * (w & 3) + r32) + 4 * hi;
#pragma unroll
            for (int r = 0; r < 16; ++r) { const int d = d0 + (r & 3) + 8 * (r >> 2);
                p0[r] = (d >= -128 && d <= 128) ? p0[r] * c : -1e30f; p1[r] = (d + 32 >= -128 && d + 32 <= 128) ? p1[r] * c : -1e30f; }
        } else {
#pragma unroll
            for (int r = 0; r < 16; ++r) { p0[r] *= c; p1[r] *= c; }
        }
    }
};
struct CfgB {
    const bf16_t* PROJ; bf16_t* YC; const LAS float* btab; int ctxu, b, gr, rs, ntiles;
    __device__ __forceinline__ int row0(int t) const { return ctxu ? MMAIN + b * CTXL + 64 * t : (t < 8 ? b * SEQ + 64 * (rs + t) : MMAIN + b * CTXL + 64 * (t - 8)); }
    __device__ __forceinline__ const bf16_t* ksrc(int row, int pl) const { return PROJ + (size_t)row * PROJ_W + PC_BK + 8 * pl; }
    __device__ __forceinline__ const bf16_t* vsrc(int row, int head) const { return PROJ + (size_t)row * PROJ_W + PC_BV + 64 * head; }
    __device__ __forceinline__ int qtok(int w, int q) const { return (ctxu ? MMAIN + b * CTXL : b * SEQ) + 64 * gr + 32 * (w & 1) + q; }
    __device__ __forceinline__ const bf16_t* qrow(int w, int r32) const { return PROJ + (size_t)qtok(w, r32) * PROJ_W + PC_BQ + 64 * (w >> 1); }
    __device__ __forceinline__ bf16_t* orow(int w, int q) const { return YC + (size_t)qtok(w, q) * DM + 256 + 64 * (w >> 1); }
    __device__ __forceinline__ int hslice(int w) const { return w >> 1; }
    __device__ __forceinline__ void fixq(bf16x8*, int, int, int) const {}
    __device__ __forceinline__ bool active(int, int) const { return true; }
    __device__ __forceinline__ float m_init(int) const { return -1e30f; }
    __device__ __forceinline__ float l_init() const { return 0.f; }
    struct State { int off0[16], off1[16]; };
    __device__ __forceinline__ void init_state(State& st, int w, int r32, int hi) const {
        const int gc = 32 * (w & 1) + r32, cs = gc - 8 < 0 ? 0 : (gc - 8 > 48 ? 48 : gc - 8);
#pragma unroll
        for (int r = 0; r < 16; ++r) { const int kc = crow(r, hi);
            st.off0[r] = ((unsigned)(kc - cs) < 16u) ? 4 * (kc - gc + 15) : 124; st.off1[r] = ((unsigned)(kc + 32 - cs) < 16u) ? 4 * (kc + 32 - gc + 15) : 124; }
    }
    __device__ __forceinline__ void transform(f32x16& p0, f32x16& p1, int t, int w, int r32, int hi, const State& st) const {
        const float c = 0.125f * LOG2E;
        if (!ctxu && t < 8) {
            const LAS unsigned char* tb = (const LAS unsigned char*)(btab + ((w >> 1) * 15 + (rs + t - gr + 7)) * 32);
#pragma unroll
            for (int r = 0; r < 16; ++r) { p0[r] = p0[r] * c + *(const LAS float*)(tb + st.off0[r]); p1[r] = p1[r] * c + *(const LAS float*)(tb + st.off1[r]); }
        } else {
#pragma unroll
            for (int r = 0; r < 16; ++r) { p0[r] *= c; p1[r] *= c; }
        }
    }
};
struct CfgC {
    const bf16_t* PROJ; const bf16_t* QCU; const bf16_t* KVU; bf16_t* YC; const float* tabC; int ctxu, b, h, qb, ntiles;
    __device__ __forceinline__ int row0(int t) const { return (ctxu || t < 4) ? MMAIN + b * CTXL + 64 * t : b * SEQ + 64 * (t - 4); }
    __device__ __forceinline__ const bf16_t* ksrc(int row, int pl) const { return pl < 8 ? KVU + (size_t)row * KVU_W + 128 * h + 8 * pl : PROJ + (size_t)row * PROJ_W + PC_CKR + 8 * (pl - 8); }
    __device__ __forceinline__ const bf16_t* vsrc(int row, int) const { return KVU + (size_t)row * KVU_W + 128 * h + 64; }
    __device__ __forceinline__ int qtok(int w, int q) const { return (ctxu ? MMAIN + b * CTXL : b * SEQ + 256 * qb) + 32 * w + q; }
    __device__ __forceinline__ const bf16_t* qrow(int w, int r32) const { return QCU + (size_t)qtok(w, r32) * QCU_W + 96 * h; }
    __device__ __forceinline__ bf16_t* orow(int w, int q) const { return YC + (size_t)qtok(w, q) * DM + 512 + 64 * h; }
    __device__ __forceinline__ void fixq(bf16x8* qr, int w, int r32, int hi) const {
        if (ctxu) return;
        const int t = 256 * qb + 32 * w + r32, pos = hi ? (t & 63) : (t >> 6);
        const f32x4 c0 = *(const f32x4*)(tabC + pos * 16), c1 = *(const f32x4*)(tabC + pos * 16 + 4), s0 = *(const f32x4*)(tabC + pos * 16 + 8), s1 = *(const f32x4*)(tabC + pos * 16 + 12);
#pragma unroll
        for (int j = 0; j < 8; ++j) { const float x1 = bf2f((bf16_t)qr[4][j]), x2 = bf2f((bf16_t)qr[5][j]), cs = j < 4 ? c0[j & 3] : c1[j & 3], sn = j < 4 ? s0[j & 3] : s1[j & 3];
            qr[4][j] = (short)f2bf(x1 * cs - x2 * sn); qr[5][j] = (short)f2bf(x1 * sn + x2 * cs); }
    }
    __device__ __forceinline__ int hslice(int) const { return 0; }
    __device__ __forceinline__ bool active(int, int) const { return true; }
    __device__ __forceinline__ float m_init(int) const { return -1e30f; }
    __device__ __forceinline__ float l_init() const { return 0.f; }
    struct State {}; __device__ __forceinline__ void init_state(State&, int, int, int) const {}
    __device__ __forceinline__ void transform(f32x16& p0, f32x16& p1, int, int, int, int, const State&) const {
        const float c = 0.10206207261596575f * LOG2E;
#pragma unroll
        for (int r = 0; r < 16; ++r) { p0[r] *= c; p1[r] *= c; }
    }
};
__device__ __forceinline__ void gmlp_unit(Frame& F, int l, int ch) {
    const bf16_t* PROJ = (const bf16_t*)(F.ws + WS_PROJ); bf16_t* YC = (bf16_t*)(F.ws + WS_YCAT); const bf16_t* WS = wl(F, l, WO_DWS);
    const float* lg = F.in[I_DLNG] + l * 256; const float* lb = F.in[I_DLNB] + l * 256; const float* bs = F.in[I_DBS] + l * 4 * 128;
    const int tid = F.tid, lane = F.lane, r32 = lane & 31, hi = lane >> 5, w = F.wave;
    __syncthreads();
    {
        const int s = tid >> 2, g = tid & 3; const bf16_t* p = PROJ + (size_t)(ch * 128 + s) * PROJ_W + PC_DV + 64 * g;
        u32x4 raw[8]; float sum = 0.f, sq = 0.f;
#pragma unroll
        for (int c = 0; c < 8; ++c) { raw[c] = *(const u32x4*)(p + 8 * c);
#pragma unroll
            for (int e = 0; e < 4; ++e) { const float a = gelu_tanh(__builtin_bit_cast(float, raw[c][e] << 16)), b2 = gelu_tanh(__builtin_bit_cast(float, raw[c][e] & 0xffff0000u)); sum += a + b2; sq += a * a + b2 * b2; } }
        sum += __shfl_xor(sum, 1); sum += __shfl_xor(sum, 2); sq += __shfl_xor(sq, 1); sq += __shfl_xor(sq, 2);
        const float mean = sum * (1.f / 256.f), var = fmaxf(sq * (1.f / 256.f) - mean * mean, 0.f);
        const float rstd = 1.f / sqrtf(var + LN_EPS);
        LAS unsigned char* img = F.lds + g * 16384 + s * 64;
#pragma unroll
        for (int c = 0; c < 8; ++c) { u32x4 o;
#pragma unroll
            for (int e = 0; e < 4; ++e) { const int i = 8 * c + 2 * e; const f32x2 gg = *(const f32x2*)(lg + 64 * g + i), bb = *(const f32x2*)(lb + 64 * g + i);
                const float a = gelu_tanh(__builtin_bit_cast(float, raw[c][e] << 16)), b2 = gelu_tanh(__builtin_bit_cast(float, raw[c][e] & 0xffff0000u));
                o[e] = cvtpk((a - mean) * rstd * gg[0] + bb[0], (b2 - mean) * rstd * gg[1] + bb[1]); }
            *(LAS u32x4*)(img + (c >> 2) * 8192 + (c & 3) * 16) = o; asm volatile("" ::: "memory"); }
    }
    __syncthreads();
    const int g = w >> 1;
    const LAS unsigned char* Vb = F.lds + g * 16384 + ((lane >> 4) & 1) * 32 + (lane & 3) * 8 + (4 * hi + ((lane & 15) >> 2)) * 64;
#pragma unroll
    for (int tbi = 0; tbi < 2; ++tbi) {
        const int tb = 2 * (w & 1) + tbi;
        const bf16_t* wrow = WS + ((size_t)g * 128 + 32 * tb + r32) * 128 + 4 * hi;
        f32x16 o0, o1;
#pragma unroll
        for (int r = 0; r < 16; ++r) { o0[r] = 0.f; o1[r] = 0.f; }
#pragma unroll
        for (int ks = 0; ks < 8; ++ks) {
            const u32x2 wa = *(const u32x2*)(wrow + 16 * ks), wb = *(const u32x2*)(wrow + 16 * ks + 8);
            const bf16x8 pa = __builtin_bit_cast(bf16x8, (u32x4){wa.x, wa.y, wb.x, wb.y});
            const s16x4 a0 = vtr(Vb + ks * 1024), a1 = vtr(Vb + ks * 1024 + 512), b0 = vtr(Vb + 8192 + ks * 1024), b1 = vtr(Vb + 8192 + ks * 1024 + 512);
            const bf16x8 v0 = {a0[0], a0[1], a0[2], a0[3], a1[0], a1[1], a1[2], a1[3]}, v1 = {b0[0], b0[1], b0[2], b0[3], b1[0], b1[1], b1[2], b1[3]};
            o0 = __builtin_amdgcn_mfma_f32_32x32x16_bf16(pa, v0, o0, 0, 0, 0);
            o1 = __builtin_amdgcn_mfma_f32_32x32x16_bf16(pa, v1, o1, 0, 0, 0);
        }
#pragma unroll
        for (int r = 0; r < 16; ++r) { const int t = 32 * tb + crow(r, hi); const size_t row = (size_t)ch * 128 + t; const float bt = bs[g * 128 + t];
            const bf16_t* up = PROJ + row * PROJ_W + PC_DU + 64 * g; bf16_t* op = YC + row * DM + 768 + 64 * g;
            op[r32] = (bf16_t)f2bf(gelu_tanh(bf2f(up[r32])) * (o0[r] + bt)); op[32 + r32] = (bf16_t)f2bf(gelu_tanh(bf2f(up[32 + r32])) * (o1[r] + bt)); }
    }
    __syncthreads();
}
template <int K, int N, bool ROPE>
__device__ __forceinline__ void upproj_unit(Frame& F, const bf16_t* A  , const bf16_t* W  , bf16_t* O  , int rt) {
    constexpr int NKS = K / 16, NCH = N / 64, CHB = K * 128;
    static_assert(2 * CHB <= RING_BYTES, "up-proj buffers");
    const int tid = F.tid, lane = F.lane, r32 = lane & 31, hi = lane >> 5, w = F.wave;
    LAS float* wsf = (LAS float*)(F.lds + WSF_OFF) + w * 64;
    const float* tabC = (const float*)(F.ws + WS_TAB) + 2048;
    auto issue = [&](int ch, int b) {
#pragma unroll
        for (int i = 0; i < NKS * 2 / 8; ++i) { const int pc = w + 8 * i, dh = pc / NKS, kb = pc % NKS;
            __builtin_amdgcn_global_load_lds((const unsigned*)(W + (size_t)(16 * kb + (lane >> 2)) * N + 64 * ch + 32 * dh + (lane & 3) * 8), (LAS unsigned*)(F.lds + b * CHB + pc * 1024), 16, 0, 0); }
    };
    issue(0, 0);
    const int row = rt * 256 + 32 * w + r32;
    const bf16_t* ap = A + (size_t)row * PROJ_W + 4 * hi;
    bf16x8 af[NKS]; float ss = 0.f;
#pragma unroll
    for (int ks = 0; ks < NKS; ++ks) { const u32x2 a = *(const u32x2*)(ap + 16 * ks), b2 = *(const u32x2*)(ap + 16 * ks + 8); const u32x4 v = {a.x, a.y, b2.x, b2.y}; af[ks] = __builtin_bit_cast(bf16x8, v);
#pragma unroll
        for (int e = 0; e < 4; ++e) { const float x0 = __builtin_bit_cast(float, v[e] << 16), x1 = __builtin_bit_cast(float, v[e] & 0xffff0000u); ss += x0 * x0 + x1 * x1; } }
    ss = swapsum(ss);
    if (hi == 0) wsf[r32] = 1.f / sqrtf(ss * (1.f / K) + LN_EPS);
    asm volatile("s_waitcnt lgkmcnt(0)" ::: "memory");
    float rs[16];
#pragma unroll
    for (int r = 0; r < 16; ++r) rs[r] = wsf[crow(r, hi)];
    const LAS unsigned char* Vl = F.lds + ((lane >> 4) & 1) * 32 + (lane & 3) * 8 + (4 * hi + ((lane & 15) >> 2)) * 64;
    const bool mainrows = rt < 64;
    asm volatile("s_waitcnt vmcnt(0)" ::: "memory"); __syncthreads();
    for (int ch = 0; ch < NCH; ++ch) {
        const int b = ch & 1;
        if (ch + 1 < NCH) issue(ch + 1, b ^ 1);
        const LAS unsigned char* Vb = Vl + b * CHB;
        f32x16 o0, o1;
#pragma unroll
        for (int r = 0; r < 16; ++r) { o0[r] = 0.f; o1[r] = 0.f; }
#pragma unroll
        for (int ks = 0; ks < NKS; ++ks) {
            const s16x4 a0 = vtr(Vb + ks * 1024), a1 = vtr(Vb + ks * 1024 + 512), b0 = vtr(Vb + K * 64 + ks * 1024), b1 = vtr(Vb + K * 64 + ks * 1024 + 512);
            const bf16x8 v0 = {a0[0], a0[1], a0[2], a0[3], a1[0], a1[1], a1[2], a1[3]}, v1 = {b0[0], b0[1], b0[2], b0[3], b1[0], b1[1], b1[2], b1[3]};
            o0 = __builtin_amdgcn_mfma_f32_32x32x16_bf16(af[ks], v0, o0, 0, 0, 0);
            o1 = __builtin_amdgcn_mfma_f32_32x32x16_bf16(af[ks], v1, o1, 0, 0, 0);
            if ((ks & 3) == 3) __builtin_amdgcn_sched_barrier(0);
        }
#pragma unroll
        for (int dh = 0; dh < 2; ++dh) {
            f32x16& o = dh ? o1 : o0;
            const int grp = 2 * ch + dh;
            const bool rope = ROPE && mainrows && (grp % 3) == 2;
#pragma unroll
            for (int r = 0; r < 16; ++r) {
                float v = o[r] * rs[r];
                const int orow = rt * 256 + 32 * w + crow(r, hi);
                if (rope) {
                    const float other = __shfl_xor(v, 16);
                    const int t = orow & 2047, p = r32 & 15, pos = (p & 8) ? (t & 63) : (t >> 6);
                    const float cs = tabC[pos * 16 + (p & 7)], sn = tabC[pos * 16 + 8 + (p & 7)];
                    v = (r32 & 16) ? (other * sn + v * cs) : (v * cs - other * sn);
                }
                O[(size_t)orow * N + 32 * grp + r32] = (bf16_t)f2bf(v);
                if ((r & 3) == 3) asm volatile("" ::: "memory");
            }
        }
        asm volatile("s_waitcnt vmcnt(0) lgkmcnt(0)" ::: "memory"); __syncthreads();
    }
}
__device__ __forceinline__ void phase_fast_abd(Frame& F, int l, bool last) {
    const bf16_t* PROJ = (const bf16_t*)(F.ws + WS_PROJ); bf16_t* YC = (bf16_t*)(F.ws + WS_YCAT);
    LAS float* btab = (LAS float*)(F.lds + BTAB_OFF);
    { const float* rpb = F.in[I_BRPB] + (size_t)l * 4 * 15 * 31;
      for (int i = F.tid; i < 60 * 32; i += NTHR) { const int c = i & 31; btab[i] = c < 31 ? rpb[(i >> 5) * 31 + c] * LOG2E : -1e30f; } }
    __syncthreads();
    const int nD = (last ? MMAIN : MALL) / 128;
    for (int u = F.bid; u < NBATCH * 32; u += F.G) { const int b = u >> 5, gr = u & 31; const int rs = gr - 4 < 0 ? 0 : (gr - 4 > 24 ? 24 : gr - 4);
        CfgB c{PROJ, YC, btab, 0, b, gr, rs, 12}; flash_unit<64, 4, CfgB>(c, F.lds, F.tid); }
    asm volatile("" : "+s"(F.ws), "+s"(F.bid), "+s"(F.G), "+s"(l));
    for (int u = F.bid; u < NBATCH * 32; u += F.G) { const int b = u >> 5, n = (u >> 1) & 15, hkv = u & 1; const int ktlo = n > 0 ? 0 : 2, kthi = n < 15 ? 5 : 3;
        CfgA c{(const bf16_t*)(F.ws + WS_PROJ), (bf16_t*)(F.ws + WS_YCAT), 0, b, n, hkv, 0, ktlo, kthi - ktlo + 1, kthi - ktlo + 1 + 4, F.in[I_ASINK][l * 4 + 2 * hkv], F.in[I_ASINK][l * 4 + 2 * hkv + 1]}; flash_unit<64, 1, CfgA>(c, F.lds, F.tid); }
    asm volatile("" : "+s"(F.ws), "+s"(F.bid), "+s"(F.G), "+s"(l));
    for (int u = F.bid; u < nD; u += F.G) gmlp_unit(F, l, u);
    asm volatile("" : "+s"(F.ws), "+s"(F.bid), "+s"(F.G), "+s"(l));
    {
        const int nq = last ? 64 : 72;
        for (int u = F.G - 1 - F.bid; u < nq + 72; u += F.G) {
            if (u < nq) upproj_unit<256, QCU_W, false>(F, (const bf16_t*)(F.ws + WS_PROJ) + PC_CQ, wl(F, l, WO_UQ), (bf16_t*)(F.ws + WS_QCU), u);
            else upproj_unit<128, KVU_W, false>(F, (const bf16_t*)(F.ws + WS_PROJ) + PC_CKV, wl(F, l, WO_UKV), (bf16_t*)(F.ws + WS_KVU), u - nq);
        }
    }
    asm volatile("" : "+s"(F.ws), "+s"(F.bid), "+s"(F.G), "+s"(l));
    if (!last) {
        const int ua = (F.bid + F.G - nD % F.G) % F.G;
        if (ua < NBATCH * 4) { const int b = ua >> 2, hq = ua & 3;
            CfgA c{(const bf16_t*)(F.ws + WS_PROJ), (bf16_t*)(F.ws + WS_YCAT), 1, b, 0, hq >> 1, hq, 0, 0, 4, F.in[I_ASINK][l * 4 + hq], 0.f}; flash_unit<64, 1, CfgA>(c, F.lds, F.tid); }
        asm volatile("" : "+s"(F.ws), "+s"(F.bid), "+s"(F.G), "+s"(l));
        const int ub = (F.bid + 2 * F.G - nD % F.G - NBATCH * 4) % F.G;
        if (ub < NBATCH * 4) { const int b = ub >> 2, pc = ub & 3; CfgB c{(const bf16_t*)(F.ws + WS_PROJ), (bf16_t*)(F.ws + WS_YCAT), btab, 1, b, pc, 0, 4}; flash_unit<64, 4, CfgB>(c, F.lds, F.tid); }
    }
    __syncthreads();
}
__device__ __forceinline__ void phase_fast_c(Frame& F, int l, bool last) {
    const bf16_t* PROJ = (const bf16_t*)(F.ws + WS_PROJ); const bf16_t* QCU = (const bf16_t*)(F.ws + WS_QCU); const bf16_t* KVU = (const bf16_t*)(F.ws + WS_KVU); bf16_t* YC = (bf16_t*)(F.ws + WS_YCAT);
    const int nC = NBATCH * 4 * 8, nCc = last ? 0 : NBATCH * 4;
    for (int u = F.bid; u < nC + nCc; u += F.G) {
        if (u < nC) { const int b = u >> 5, h = (u >> 3) & 3, qb = u & 7; CfgC c{PROJ, QCU, KVU, YC, (const float*)(F.ws + WS_TAB) + 2048, 0, b, h, qb, 36}; flash_unit<96, 1, CfgC>(c, F.lds, F.tid); }
        else { const int r = u - nC, b = r >> 2, h = r & 3; CfgC c{PROJ, QCU, KVU, YC, (const float*)(F.ws + WS_TAB) + 2048, 1, b, h, 0, 4}; flash_unit<96, 1, CfgC>(c, F.lds, F.tid); }
    }
    __syncthreads();
}

struct KSrc { const bf16_t* k1; int k1ld; const bf16_t* k2; int k2ld; const bf16_t* v; int vld; };
template <class KeyFn> __device__ __forceinline__ void naive_attn_row(const bf16_t* q, int nkeys, const KSrc& ks, KeyFn kf, bool has_sink, float sink, float scale, bf16_t* out,
                                                                        LAS float* sc, LAS unsigned short* rowi, LAS float* qf, int lane) {
    const int dqk = ks.k2 ? 96 : 64;
    for (int d = lane; d < dqk; d += 64) qf[d] = bf2f(q[d]);
    asm volatile("s_waitcnt lgkmcnt(0)" ::: "memory");
    float mx = has_sink ? sink : -1e30f;
    for (int kk = lane; kk < nkeys; kk += 64) {
        int row; float bias; kf(kk, row, bias);
        float dot = 0.f;
        const bf16_t* kp = ks.k1 + (size_t)row * ks.k1ld;
#pragma unroll
        for (int c = 0; c < 8; ++c) { const u32x4 w = *(const u32x4*)(kp + 8 * c);
#pragma unroll
            for (int e = 0; e < 4; ++e) { dot += qf[8 * c + 2 * e] * __builtin_bit_cast(float, w[e] << 16) + qf[8 * c + 2 * e + 1] * __builtin_bit_cast(float, w[e] & 0xffff0000u); } }
        if (ks.k2) { const bf16_t* kp2 = ks.k2 + (size_t)row * ks.k2ld;
#pragma unroll
            for (int c = 0; c < 4; ++c) { const u32x4 w = *(const u32x4*)(kp2 + 8 * c);
#pragma unroll
                for (int e = 0; e < 4; ++e) { dot += qf[64 + 8 * c + 2 * e] * __builtin_bit_cast(float, w[e] << 16) + qf[64 + 8 * c + 2 * e + 1] * __builtin_bit_cast(float, w[e] & 0xffff0000u); } } }
        const float s = dot * scale + bias;
        sc[kk] = s; rowi[kk] = (unsigned short)row; mx = fmaxf(mx, s);
    }
    mx = wave_max(mx);
    float sum = 0.f;
    for (int kk = lane; kk < nkeys; kk += 64) { const float p = __expf(sc[kk] - mx); sc[kk] = p; sum += p; }
    sum = wave_sum(sum); if (has_sink) sum += __expf(sink - mx);
    asm volatile("s_waitcnt lgkmcnt(0)" ::: "memory");
    float a0 = 0.f, a1 = 0.f, a2 = 0.f, a3 = 0.f;
    const bf16_t* vb = ks.v + lane;
    int kk = 0;
    for (; kk + 4 <= nkeys; kk += 4) {
        a0 += sc[kk] * bf2f(vb[(size_t)rowi[kk] * ks.vld]); a1 += sc[kk + 1] * bf2f(vb[(size_t)rowi[kk + 1] * ks.vld]);
        a2 += sc[kk + 2] * bf2f(vb[(size_t)rowi[kk + 2] * ks.vld]); a3 += sc[kk + 3] * bf2f(vb[(size_t)rowi[kk + 3] * ks.vld]);
    }
    for (; kk < nkeys; ++kk) a0 += sc[kk] * bf2f(vb[(size_t)rowi[kk] * ks.vld]);
    out[lane] = (bf16_t)f2bf(((a0 + a1) + (a2 + a3)) / sum);
    asm volatile("s_waitcnt lgkmcnt(0)" ::: "memory");
}
__device__ __forceinline__ void phase_naive_ab(Frame& F, int l, bool last) {
    const bf16_t* PROJ = (const bf16_t*)(F.ws + WS_PROJ); bf16_t* YC = (bf16_t*)(F.ws + WS_YCAT);
    LAS float* sc = (LAS float*)(F.lds + F.wave * 16384); LAS unsigned short* rowi = (LAS unsigned short*)(F.lds + F.wave * 16384 + 4096); LAS float* qf = (LAS float*)(F.lds + F.wave * 16384 + 8192);
    const int gw = F.bid * NWAVES + F.wave, NGW = F.G * NWAVES;
    const int mrows = last ? MMAIN : MALL;
    for (int task = gw; task < mrows * 4; task += NGW) {
        const int r = task >> 2, hq = task & 3, hkv = hq >> 1;
        const float sink = F.in[I_ASINK][l * 4 + hq];
        KSrc ks{PROJ + PC_AK + 64 * hkv, PROJ_W, nullptr, 0, PROJ + PC_AV + 64 * hkv, PROJ_W};
        const bf16_t* q = PROJ + (size_t)r * PROJ_W + PC_AQ + 64 * hq; bf16_t* o = YC + (size_t)r * DM + 64 * hq;
        if (r < MMAIN) {
            const int b = r >> 11, t = r & 2047, lo = t - 128 < 0 ? 0 : t - 128, hi = t + 128 > 2047 ? 2047 : t + 128, nloc = hi - lo + 1;
            auto kf = [&](int kk, int& row, float& bias) { bias = 0.f; row = kk < nloc ? b * SEQ + lo + kk : MMAIN + b * CTXL + (kk - nloc); };
            naive_attn_row(q, nloc + CTXL, ks, kf, true, sink, 0.125f, o, sc, rowi, qf, F.lane);
        } else {
            const int b = (r - MMAIN) >> 8;
            auto kf = [&](int kk, int& row, float& bias) { bias = 0.f; row = MMAIN + b * CTXL + kk; };
            naive_attn_row(q, CTXL, ks, kf, true, sink, 0.125f, o, sc, rowi, qf, F.lane);
        }
    }
    const float* rpb = F.in[I_BRPB] + (size_t)l * 4 * 15 * 31;
    for (int task = gw; task < mrows * 4; task += NGW) {
        const int r = task >> 2, h = task & 3;
        KSrc ks{PROJ + PC_BK + 64 * h, PROJ_W, nullptr, 0, PROJ + PC_BV + 64 * h, PROJ_W};
        const bf16_t* q = PROJ + (size_t)r * PROJ_W + PC_BQ + 64 * h; bf16_t* o = YC + (size_t)r * DM + 256 + 64 * h;
        if (r < MMAIN) {
            const int b = r >> 11, t = r & 2047, gr = t >> 6, gc = t & 63;
            const int rs = gr - 4 < 0 ? 0 : (gr - 4 > 24 ? 24 : gr - 4), cs = gc - 8 < 0 ? 0 : (gc - 8 > 48 ? 48 : gc - 8);
            auto kf = [&](int kk, int& row, float& bias) {
                if (kk < 128) { const int jr = kk >> 4, kc = cs + (kk & 15), kr = rs + jr; row = b * SEQ + kr * 64 + kc; bias = rpb[(h * 15 + (kr - gr + 7)) * 31 + (kc - gc + 15)]; }
                else { row = MMAIN + b * CTXL + (kk - 128); bias = 0.f; } };
            naive_attn_row(q, 128 + CTXL, ks, kf, false, 0.f, 0.125f, o, sc, rowi, qf, F.lane);
        } else {
            const int b = (r - MMAIN) >> 8;
            auto kf = [&](int kk, int& row, float& bias) { bias = 0.f; row = MMAIN + b * CTXL + kk; };
            naive_attn_row(q, CTXL, ks, kf, false, 0.f, 0.125f, o, sc, rowi, qf, F.lane);
        }
    }
}
__device__ __forceinline__ void phase_naive_c(Frame& F, int l, bool last) {
    const bf16_t* PROJ = (const bf16_t*)(F.ws + WS_PROJ); const bf16_t* QCU = (const bf16_t*)(F.ws + WS_QCU); const bf16_t* KVU = (const bf16_t*)(F.ws + WS_KVU); bf16_t* YC = (bf16_t*)(F.ws + WS_YCAT);
    LAS float* sc = (LAS float*)(F.lds + F.wave * 16384); LAS unsigned short* rowi = (LAS unsigned short*)(F.lds + F.wave * 16384 + 9216); LAS float* qf = (LAS float*)(F.lds + F.wave * 16384 + 13824);
    const int gw = F.bid * NWAVES + F.wave, NGW = F.G * NWAVES;
    const int mrows = last ? MMAIN : MALL;
    const float scale = 0.10206207261596575f;
    for (int task = gw; task < mrows * 4; task += NGW) {
        const int r = task >> 2, h = task & 3;
        KSrc ks{KVU + 128 * h, KVU_W, PROJ + PC_CKR, PROJ_W, KVU + 128 * h + 64, KVU_W};
        const bf16_t* q = QCU + (size_t)r * QCU_W + 96 * h; bf16_t* o = YC + (size_t)r * DM + 512 + 64 * h;
        if (r < MMAIN) {
            const int b = r >> 11;
            auto kf = [&](int kk, int& row, float& bias) { bias = 0.f; row = kk < CTXL ? MMAIN + b * CTXL + kk : b * SEQ + (kk - CTXL); };
            naive_attn_row(q, CTXL + SEQ, ks, kf, false, 0.f, scale, o, sc, rowi, qf, F.lane);
        } else {
            const int b = (r - MMAIN) >> 8;
            auto kf = [&](int kk, int& row, float& bias) { bias = 0.f; row = MMAIN + b * CTXL + kk; };
            naive_attn_row(q, CTXL, ks, kf, false, 0.f, scale, o, sc, rowi, qf, F.lane);
        }
    }
}
__device__ __forceinline__ void phase_naive_d(Frame& F, int l, bool last) {
    const bf16_t* PROJ = (const bf16_t*)(F.ws + WS_PROJ); bf16_t* YC = (bf16_t*)(F.ws + WS_YCAT);
    LAS float* vln = (LAS float*)(F.lds);
    const float* lg = F.in[I_DLNG] + l * 256; const float* lb = F.in[I_DLNB] + l * 256;
    const float* ws = F.in[I_DWS] + (size_t)l * 4 * 128 * 128; const float* bs = F.in[I_DBS] + l * 4 * 128;
    const int nchunk = (last ? MMAIN : MALL) / 128;
    for (int ch = F.bid; ch < nchunk; ch += F.G) {
        __syncthreads();
        for (int i = 0; i < 16; ++i) { const int rl = F.wave * 16 + i; const bf16_t* p = PROJ + (size_t)(ch * 128 + rl) * PROJ_W + PC_DV + 4 * F.lane;
            const u32x2 w = *(const u32x2*)p; float x[4] = {__builtin_bit_cast(float, w.x << 16), __builtin_bit_cast(float, w.x & 0xffff0000u), __builtin_bit_cast(float, w.y << 16), __builtin_bit_cast(float, w.y & 0xffff0000u)};
            float s = 0.f;
#pragma unroll
            for (int e = 0; e < 4; ++e) { x[e] = gelu_tanh(x[e]); s += x[e]; }
            const float mean = wave_sum(s) * (1.f / 256.f); float s2 = 0.f;
#pragma unroll
            for (int e = 0; e < 4; ++e) { x[e] -= mean; s2 += x[e] * x[e]; }
            const float rstd = 1.f / sqrtf(wave_sum(s2) * (1.f / 256.f) + LN_EPS);
#pragma unroll
            for (int e = 0; e < 4; ++e) vln[rl * 256 + 4 * F.lane + e] = x[e] * rstd * lg[4 * F.lane + e] + lb[4 * F.lane + e]; }
        __syncthreads();
        const int chn = F.tid & 255, g = chn >> 6, t0 = (F.tid >> 8) * 64;
        for (int t = t0; t < t0 + 64; ++t) { const float* wr = ws + ((size_t)g * 128 + t) * 128; float a0 = 0.f, a1 = 0.f;
#pragma unroll 8
            for (int s = 0; s < 128; s += 2) { a0 += wr[s] * vln[s * 256 + chn]; a1 += wr[s + 1] * vln[(s + 1) * 256 + chn]; }
            const float mixed = a0 + a1 + bs[g * 128 + t];
            const size_t row = (size_t)ch * 128 + t; const float u = gelu_tanh(bf2f(PROJ[row * PROJ_W + PC_DU + chn]));
            YC[row * DM + 768 + chn] = (bf16_t)f2bf(u * mixed); }
    }
    __syncthreads();
}
__device__ __forceinline__ void phase_naive_up(Frame& F, int l, bool last) {
    const bf16_t* PROJ = (const bf16_t*)(F.ws + WS_PROJ); bf16_t* QCU = (bf16_t*)(F.ws + WS_QCU); bf16_t* KVU = (bf16_t*)(F.ws + WS_KVU);
    const float* tabC = (const float*)(F.ws + WS_TAB) + 2048;
    LAS float* av = (LAS float*)(F.lds + F.wave * 16384);
    LAS float* ov = (LAS float*)(F.lds + F.wave * 16384 + 2048);
    const int gw = F.bid * NWAVES + F.wave, NGW = F.G * NWAVES;
    const float* wq = F.in[I_WUQ] + (size_t)l * 256 * QCU_W; const float* wkv = F.in[I_WUKV] + (size_t)l * 128 * KVU_W;
    const float* gq = F.in[I_CQN] + l * 256; const float* gkv = F.in[I_CKVN] + l * 128;
    for (int r = gw; r < MALL; r += NGW) {
        const int t = r & 2047; const bool mainr = r < MMAIN;
        if (!(last && !mainr)) {
            float ss = 0.f; float x[4];
#pragma unroll
            for (int j = 0; j < 4; ++j) { x[j] = bf2f(PROJ[(size_t)r * PROJ_W + PC_CQ + F.lane + 64 * j]); ss += x[j] * x[j]; }
            const float rstd = 1.f / sqrtf(wave_sum(ss) * (1.f / 256.f) + LN_EPS);
#pragma unroll
            for (int j = 0; j < 4; ++j) av[F.lane + 64 * j] = x[j] * rstd * gq[F.lane + 64 * j];
            asm volatile("s_waitcnt lgkmcnt(0)" ::: "memory");
            float o[6] = {0.f, 0.f, 0.f, 0.f, 0.f, 0.f};
            for (int k = 0; k < 256; ++k) { const float a = av[k];
#pragma unroll
                for (int j = 0; j < 6; ++j) o[j] += a * wq[(size_t)k * QCU_W + F.lane + 64 * j]; }
#pragma unroll
            for (int j = 0; j < 6; ++j) ov[F.lane + 64 * j] = o[j];
            asm volatile("s_waitcnt lgkmcnt(0)" ::: "memory");
#pragma unroll
            for (int j = 0; j < 6; ++j) { const int n = F.lane + 64 * j, h = n / 96, e = n % 96; float val;
                if (e < 64) val = ov[n];
                else { const int p = e - 64, d = perm_c(p);
                    const float xv = ov[h * 96 + 64 + d];
                    if (!mainr) val = xv;
                    else { const int hf = d >> 4, i = d & 7, second = (d >> 3) & 1;
                        const int pos = hf ? (t & 63) : (t >> 6); const float cs = tabC[pos * 16 + i], sn = tabC[pos * 16 + 8 + i];
                        const float other = ov[h * 96 + 64 + (d ^ 8)];
                        val = second ? (other * sn + xv * cs) : (xv * cs - other * sn); } }
                QCU[(size_t)r * QCU_W + n] = (bf16_t)f2bf(val); }
            asm volatile("s_waitcnt lgkmcnt(0)" ::: "memory");
        }
        {
            float ss = 0.f; float x[2];
#pragma unroll
            for (int j = 0; j < 2; ++j) { x[j] = bf2f(PROJ[(size_t)r * PROJ_W + PC_CKV + F.lane + 64 * j]); ss += x[j] * x[j]; }
            const float rstd = 1.f / sqrtf(wave_sum(ss) * (1.f / 128.f) + LN_EPS);
#pragma unroll
            for (int j = 0; j < 2; ++j) av[F.lane + 64 * j] = x[j] * rstd * gkv[F.lane + 64 * j];
            asm volatile("s_waitcnt lgkmcnt(0)" ::: "memory");
            float o[8] = {0.f, 0.f, 0.f, 0.f, 0.f, 0.f, 0.f, 0.f};
            for (int k = 0; k < 128; ++k) { const float a = av[k];
#pragma unroll
                for (int j = 0; j < 8; ++j) o[j] += a * wkv[(size_t)k * KVU_W + F.lane + 64 * j]; }
#pragma unroll
            for (int j = 0; j < 8; ++j) KVU[(size_t)r * KVU_W + F.lane + 64 * j] = (bf16_t)f2bf(o[j]);
            asm volatile("s_waitcnt lgkmcnt(0)" ::: "memory");
        }
    }
}
__device__ __forceinline__ void unit_rstd(Frame& F, const pg8::StaticOrder& S, const bf16_t* A, int lda, int ncol) {
    pg8::Unit u; LAS float* rs = (LAS float*)(F.lds + TABL_OFF);
    __syncthreads();
    if (S.next(0, u)) {
        const int r = F.tid >> 1, hf = F.tid & 1, n8 = ncol / 16;
        const bf16_t* p = A + (size_t)(u.pm * 256 + r) * lda + hf * (ncol / 2); float s = 0.f;
        for (int c = 0; c < n8; ++c) { const u32x4 w = *(const u32x4*)(p + 8 * c);
#pragma unroll
            for (int e = 0; e < 4; ++e) { const float a = __builtin_bit_cast(float, w[e] << 16), b = __builtin_bit_cast(float, w[e] & 0xffff0000u); s += a * a + b * b; } }
        s += __shfl_xor(s, 1);
        if (hf == 0) rs[r] = 1.f / sqrtf(s / (float)ncol + LN_EPS);
    }
    __syncthreads();
}

constexpr int NPHASE = 2 + 8 * DEPTH;
#define IN(k) (lo <= (k) && (k) < hi)
#define SEAM(k) do { if (use_bar && (k) + 1 < hi) xcd_barrier(bar); } while (0)
#define FRESH() asm volatile("" : "+s"(F.ws), "+s"(F.out), "+s"(F.bid), "+s"(F.G))
template <int l> __device__ __forceinline__ void layer_phases(Frame& F, const XcdBarrier& bar, const int lo, const int hi, const int use_bar) {
    constexpr int p0 = 2 + 8 * l;
        if (IN(p0 + 0)) {
            FRESH();
            pg8::Gemm g{(const bf16_t*)(F.ws + WS_H), wl(F, l, WO_IN), MALL, PROJ_W, DM, DM}; pg8::StaticOrder S; S.init(MALL, PROJ_W, F.G, F.bid);
            pg8::EpiProj E{(bf16_t*)(F.ws + WS_PROJ), PROJ_W, (const float*)(F.ws + WS_TAB), (const float*)(F.ws + WS_TAB) + 2048};
            pg8::gemm_phase<pg8::EpiProj, pg8::StaticOrder, true, true>(F.lds, g, S, E);
            SEAM(p0 + 0);
        }
        if (IN(p0 + 1)) {
            FRESH();
#if !USE_FAST_ABD
            phase_naive_up(F, l, l == DEPTH - 1);
#endif
            __syncthreads();
#if USE_FAST_ABD
            phase_fast_abd(F, l, l == DEPTH - 1);
#else
            phase_naive_ab(F, l, l == DEPTH - 1);
            phase_naive_d(F, l, l == DEPTH - 1);
#endif
            SEAM(p0 + 1);
        }
        if (IN(p0 + 2)) { FRESH();
#if USE_FAST_C
            phase_fast_c(F, l, l == DEPTH - 1);
#else
            phase_naive_c(F, l, l == DEPTH - 1);
#endif
            SEAM(p0 + 2); }
        if (IN(p0 + 3)) {
            FRESH();
            const int mrows = (l == DEPTH - 1) ? MMAIN : MALL;
            pg8::Gemm g{(const bf16_t*)(F.ws + WS_YCAT), wl(F, l, WO_OUT), mrows, DM, DM, DM}; pg8::StaticOrder S; S.init(mrows, DM, F.G, F.bid);
            pg8::EpiResid E{F.out, (float*)(F.ws + WS_XC), (const float*)(F.ws + WS_MOD) + (size_t)l * 9 * MODW + 2 * DM};
            pg8::gemm_phase<pg8::EpiResid, pg8::StaticOrder, true, true>(F.lds, g, S, E);
            SEAM(p0 + 3);
        }
        if (IN(p0 + 4)) { FRESH(); phase_ln(F, (l == DEPTH - 1) ? MMAIN : MALL, F.in[I_LN1G] + l * DM, F.in[I_LN1B] + l * DM, (const float*)(F.ws + WS_MOD) + (size_t)l * 9 * MODW, 3, 4); SEAM(p0 + 4); }
        if (IN(p0 + 5)) {
            FRESH();
            const int mrows = (l == DEPTH - 1) ? MMAIN : MALL;
            pg8::Gemm g{(const bf16_t*)(F.ws + WS_H), wl(F, l, WO_GU), mrows, 2 * FF, DM, DM}; pg8::StaticOrder S; S.init(mrows, 2 * FF, F.G, F.bid);
            pg8::EpiGu E{(bf16_t*)(F.ws + WS_ACT)};
            pg8::gemm_phase<pg8::EpiGu, pg8::StaticOrder, true, true>(F.lds, g, S, E);
            SEAM(p0 + 5);
        }
        if (IN(p0 + 6)) {
            FRESH();
            const int mrows = (l == DEPTH - 1) ? MMAIN : MALL;
            pg8::Gemm g{(const bf16_t*)(F.ws + WS_ACT), wl(F, l, WO_DN), mrows, DM, FF, FF}; pg8::StaticOrder S; S.init(mrows, DM, F.G, F.bid);
            pg8::EpiResid E{F.out, (float*)(F.ws + WS_XC), (const float*)(F.ws + WS_MOD) + (size_t)l * 9 * MODW + 5 * DM};
            pg8::gemm_phase<pg8::EpiResid, pg8::StaticOrder, true, true>(F.lds, g, S, E);
            SEAM(p0 + 6);
        }
        if (IN(p0 + 7)) { FRESH(); const bool last = (l == DEPTH - 1);
            phase_ln(F, last ? MMAIN : MALL, F.in[I_LN2G] + l * DM, F.in[I_LN2B] + l * DM, last ? nullptr : (const float*)(F.ws + WS_MOD) + (size_t)(l + 1) * 9 * MODW, 0, 1); SEAM(p0 + 7); }
}
__global__ void __launch_bounds__(NTHR, 2) mk_fwd(Args args) {
    extern __shared__ __attribute__((aligned(16))) unsigned char lds_raw[];
    Frame F; F.lds = (LAS unsigned char*)lds_raw; F.tid = threadIdx.x; F.lane = F.tid & 63; F.wave = __builtin_amdgcn_readfirstlane(F.tid >> 6);
    F.G = gridDim.x; F.bid = blockIdx.x; F.in = args.in; F.out = args.out; F.ws = args.ws;
    for (int u = F.tid; u < (LDS_BYTES - LDSCTL_OFF) / 4; u += NTHR) ((LAS unsigned*)(F.lds + LDSCTL_OFF))[u] = 0u;
    __syncthreads();
    XcdBarrier bar; bar.bar = (unsigned*)(F.ws + WS_CTL) + CW_BAR; bar.x = 0; bar.st = nullptr;
    const int use_bar = args.use_bar;
    if (use_bar) bar = xcd_barrier_post((unsigned*)(F.ws + WS_CTL) + CW_BAR, (volatile LAS unsigned*)(F.lds + LDSCTL_OFF + 64));
    const int lo = args.ph_lo, hi = args.ph_hi;
    if (IN(0)) { phase_prologue0(F); SEAM(0); }
    if (IN(1)) { phase_prologue1(F); SEAM(1); }
    layer_phases<0>(F, bar, lo, hi, use_bar);
    layer_phases<1>(F, bar, lo, hi, use_bar);
    layer_phases<2>(F, bar, lo, hi, use_bar);
    layer_phases<3>(F, bar, lo, hi, use_bar);
}
#undef IN
#undef SEAM
#undef FRESH

extern "C" void kernel_launch(void* const* d_in, const int* in_sizes, int n_in, void* d_out, int out_size, void* d_ws, size_t ws_size, hipStream_t stream) {
    static int grid = 0;
    if (grid == 0) {
        if (n_in != 24 || out_size != MMAIN * DM || ws_size < WS_END) { fprintf(stderr, "kernel_launch: unexpected shapes (n_in %d out %d ws %zu need %zu)\n", n_in, out_size, ws_size, (size_t)WS_END); grid = -1; return; }
        int dev = 0, cus = 0, per_cu = 0;
        hipGetDevice(&dev); hipDeviceGetAttribute(&cus, hipDeviceAttributeMultiprocessorCount, dev);
        hipFuncSetAttribute((const void*)mk_fwd, hipFuncAttributeMaxDynamicSharedMemorySize, LDS_BYTES);
        hipOccupancyMaxActiveBlocksPerMultiprocessor(&per_cu, (const void*)mk_fwd, NTHR, LDS_BYTES);
        (void)hipGetLastError();
        if (per_cu < 1) fprintf(stderr, "kernel_launch: occupancy query says %d blocks per CU\n", per_cu);
        grid = cus > 0 ? cus : 256;
    }
    if (grid < 0) return;
    hipMemsetAsync((char*)d_ws + WS_CTL, 0, CTL_ZERO_BYTES, stream);
    Args a{};
    for (int i = 0; i < 24; ++i) a.in[i] = (const float*)d_in[i];
    a.out = (float*)d_out; a.ws = (unsigned char*)d_ws;
#if MK_ONE_LAUNCH
    a.ph_lo = 0; a.ph_hi = NPHASE; a.use_bar = 1;
    void* kargs[] = {&a};
    hipError_t e = hipLaunchCooperativeKernel((const void*)mk_fwd, dim3(grid), dim3(NTHR), kargs, LDS_BYTES, stream);
    if (e != hipSuccess) fprintf(stderr, "cooperative launch failed: %s (grid %d)\n", hipGetErrorString(e), grid);
#else
    a.use_bar = 0;
    for (int ph = 0; ph < NPHASE; ++ph) { a.ph_lo = ph; a.ph_hi = ph + 1; hipLaunchKernelGGL(mk_fwd, dim3(grid), dim3(NTHR), LDS_BYTES, stream, a); }
#endif
}
```
